# Optimizing an MI355X kernel written in HIP

```python
import jax, jax.numpy as jnp
from jax import lax
import numpy as np

D_MODEL = 1024
BATCH = 8
SEQ = 2048
DEPTH = 4

D_PLE = 256
HEAD_DIM = 64
FOX_WIDTH = D_MODEL // 2
FOX_HEADS = FOX_WIDTH // HEAD_DIM
HGRN_WIDTH = D_MODEL // 2
HGRN_HEADS = HGRN_WIDTH // HEAD_DIM
HGRN_KEY_DIM = HEAD_DIM
HGRN_VAL_DIM = HEAD_DIM
D_MIX = FOX_WIDTH + HGRN_WIDTH
IN_SPLIT_SIZES = (FOX_WIDTH, FOX_WIDTH, FOX_WIDTH, FOX_HEADS, HGRN_WIDTH, HGRN_WIDTH, HGRN_WIDTH, HGRN_WIDTH)
D_IN = sum(IN_SPLIT_SIZES)
IN_SPLIT_IDX = tuple(int(v) for v in np.cumsum(IN_SPLIT_SIZES)[:-1])
Q_BLOCK = 128
CHUNK = 64
D_FF = 2816
N_EXPERTS = 8
TOP_K = 2
D_EXPERT = 3584
N_DENSE = (DEPTH + 1) // 2
N_MOE = DEPTH // 2
EPS = 1e-6

kernel_name = "hybrid_fox_hgrn2_moe_ple_trunk"


def rmsnorm(x, gain):
    xf = x.astype(jnp.float32)
    y = xf * lax.rsqrt(jnp.mean(xf * xf, axis=-1, keepdims=True) + EPS)
    return (y * gain.astype(jnp.float32)).astype(x.dtype)


def head_rmsnorm(x, gain, n_heads):
    b, s, w = x.shape
    xh = x.reshape(b, s, n_heads, w // n_heads)
    return rmsnorm(xh, gain.reshape(n_heads, w // n_heads)).reshape(b, s, w)


def forgetting_attention(q, k, v, fgate_logit, fgate_bias):
    b, s, _ = q.shape
    h, dh = FOX_HEADS, HEAD_DIM
    q = q.reshape(b, s, h, dh)
    k = k.reshape(b, s, h, dh)
    v = v.reshape(b, s, h, dh)
    log_f = jax.nn.log_sigmoid(fgate_logit.astype(jnp.float32) + fgate_bias.astype(jnp.float32))
    c = jnp.cumsum(log_f, axis=1).transpose(0, 2, 1)
    nb = s // Q_BLOCK
    q_blocks = q.reshape(b, nb, Q_BLOCK, h, dh).transpose(1, 0, 3, 2, 4)
    c_blocks = c.reshape(b, h, nb, Q_BLOCK).transpose(2, 0, 1, 3)
    starts = jnp.arange(nb, dtype=jnp.int32) * Q_BLOCK
    k_pos = jnp.arange(s, dtype=jnp.int32)
    scale = dh ** -0.5

    def attend_block(args):
        q_blk, c_blk, start = args
        logits = jnp.einsum('bhqd,bkhd->bhqk', q_blk, k, preferred_element_type=jnp.float32) * scale
        logits = logits + c_blk[..., None] - c[:, :, None, :]
        q_pos = start + jnp.arange(Q_BLOCK, dtype=jnp.int32)
        causal = k_pos[None, :] <= q_pos[:, None]
        probs = jax.nn.softmax(jnp.where(causal, logits, -jnp.inf), axis=-1)
        return jnp.einsum('bhqk,bkhd->bqhd', probs.astype(v.dtype), v)

    out = lax.map(attend_block, (q_blocks, c_blocks, starts))
    return out.transpose(1, 0, 2, 3, 4).reshape(b, s, h * dh)


def hgrn2_recurrence(q, f_logit, i_in, lower_bound):
    b, s, _ = q.shape
    h, dk, dv = HGRN_HEADS, HGRN_KEY_DIM, HGRN_VAL_DIM
    f32 = jnp.float32
    lb = lower_bound.astype(f32).reshape(h, dk)
    log_f = jnp.logaddexp(jnp.log(lb), jnp.log1p(-lb) + jax.nn.log_sigmoid(f_logit.astype(f32).reshape(b, s, h, dk)))
    key = -jnp.expm1(log_f)
    nc = s // CHUNK

    def to_chunks(a, d):
        return a.reshape(b, nc, CHUNK, h, d).transpose(1, 0, 3, 2, 4)

    q_c = to_chunks(q.astype(f32), dk)
    k_c = to_chunks(key, dk)
    v_c = to_chunks(i_in.astype(f32), dv)
    b_c = jnp.cumsum(to_chunks(log_f, dk), axis=3)
    causal = jnp.tril(jnp.ones((CHUNK, CHUNK), dtype=bool))[:, :, None]

    def chunk_step(state, inp):
        q_t, k_t, v_t, b_t = inp
        decay = jnp.exp(jnp.where(causal, b_t[:, :, :, None, :] - b_t[:, :, None, :, :], -jnp.inf))
        scores = jnp.einsum('bhtd,bhsd,bhtsd->bhts', q_t, k_t, decay)
        out = jnp.einsum('bhts,bhsv->bhtv', scores, v_t) + jnp.einsum('bhtd,bhdv->bhtv', q_t * jnp.exp(b_t), state)
        b_end = b_t[:, :, -1:, :]
        new_state = jnp.exp(b_end[:, :, 0, :])[..., None] * state + jnp.einsum('bhsd,bhsv->bhdv', k_t * jnp.exp(b_end - b_t), v_t)
        return new_state, out

    state0 = jnp.zeros((b, h, dk, dv), f32)
    _, o = lax.scan(chunk_step, state0, (q_c, k_c, v_c, b_c))
    return o.transpose(1, 0, 3, 2, 4).reshape(b, s, h * dv).astype(q.dtype)


def swiglu(u, w_gate, w_up, w_down):
    return (jax.nn.silu(u @ w_gate) * (u @ w_up)) @ w_down


def moe_swiglu(u, w_router, w_gate, w_up, w_down):
    b, s, d = u.shape
    t = u.reshape(b * s, d)
    logits = jnp.dot(t, w_router, preferred_element_type=jnp.float32)
    top_logit, top_idx = lax.top_k(logits, TOP_K)
    top_w = jax.nn.softmax(top_logit, axis=-1)
    gate = jnp.einsum('tk,tke->te', top_w, jax.nn.one_hot(top_idx, N_EXPERTS, dtype=jnp.float32)).astype(u.dtype)
    out = jnp.zeros_like(t)
    for e in range(N_EXPERTS):
        out = out + gate[:, e:e + 1] * swiglu(t, w_gate[e], w_up[e], w_down[e])
    return out.reshape(b, s, d)


def setup_inputs(seed: int = 0) -> dict:
    key = jax.random.key(seed)
    ks = jax.random.split(key, 21)

    def nrm(k, shape, scale):
        return jax.random.normal(k, shape, jnp.float32) * scale

    def gain(k, shape):
        return 1.0 + nrm(k, shape, 0.02)

    return {
        'x': nrm(ks[0], (BATCH, SEQ, D_MODEL), 1.0),
        'p': nrm(ks[1], (DEPTH, BATCH, SEQ, D_PLE), 1.0),
        'w_in': nrm(ks[2], (DEPTH, D_MODEL, D_IN), D_MODEL ** -0.5),
        'fox_gate_bias': 2.0 + nrm(ks[3], (DEPTH, FOX_HEADS), 0.5),
        'fox_out_gain': gain(ks[4], (DEPTH, FOX_WIDTH)),
        'hgrn_lb_logits': nrm(ks[5], (DEPTH, HGRN_WIDTH), 0.1),
        'hgrn_out_gain': gain(ks[6], (DEPTH, HGRN_WIDTH)),
        'w_out': nrm(ks[7], (DEPTH, D_MIX, D_MODEL), D_MIX ** -0.5),
        'mix_norm_gain': gain(ks[8], (DEPTH, D_MODEL)),
        'ffn_norm_gain': gain(ks[9], (DEPTH, D_MODEL)),
        'ple_norm_gain': gain(ks[10], (DEPTH, D_MODEL)),
        'w_ffn_gate': nrm(ks[11], (N_DENSE, D_MODEL, D_FF), D_MODEL ** -0.5),
        'w_ffn_up': nrm(ks[12], (N_DENSE, D_MODEL, D_FF), D_MODEL ** -0.5),
        'w_ffn_down': nrm(ks[13], (N_DENSE, D_FF, D_MODEL), D_FF ** -0.5),
        'w_router': nrm(ks[14], (N_MOE, D_MODEL, N_EXPERTS), D_MODEL ** -0.5),
        'w_exp_gate': nrm(ks[15], (N_MOE, N_EXPERTS, D_MODEL, D_EXPERT), D_MODEL ** -0.5),
        'w_exp_up': nrm(ks[16], (N_MOE, N_EXPERTS, D_MODEL, D_EXPERT), D_MODEL ** -0.5),
        'w_exp_down': nrm(ks[17], (N_MOE, N_EXPERTS, D_EXPERT, D_MODEL), D_EXPERT ** -0.5),
        'w_ple': nrm(ks[18], (DEPTH, D_PLE, D_MODEL), D_PLE ** -0.5),
        'w_ple_gate': nrm(ks[19], (DEPTH, D_MODEL, D_MODEL), D_MODEL ** -0.5),
        'final_norm_gain': gain(ks[20], (D_MODEL,)),
    }


def reference(x, p, w_in, fox_gate_bias, fox_out_gain, hgrn_lb_logits, hgrn_out_gain, w_out, mix_norm_gain, ffn_norm_gain, ple_norm_gain, w_ffn_gate, w_ffn_up, w_ffn_down, w_router, w_exp_gate, w_exp_up, w_exp_down, w_ple, w_ple_gate, final_norm_gain):
    lb_cum = jnp.cumsum(jax.nn.softmax(hgrn_lb_logits.astype(jnp.float32), axis=0), axis=0)
    lower_bounds = lb_cum - lb_cum[0:1]
    h = x
    for i in range(DEPTH):
        u = rmsnorm(h, mix_norm_gain[i])
        z = u @ w_in[i]
        fq, fk, fv, fg, hq, hf, hi, hg = jnp.split(z, IN_SPLIT_IDX, axis=-1)
        a_out = head_rmsnorm(forgetting_attention(fq, fk, fv, fg, fox_gate_bias[i]), fox_out_gain[i], FOX_HEADS)
        r_out = head_rmsnorm(hgrn2_recurrence(hq, hf, hi, lower_bounds[i]), hgrn_out_gain[i], HGRN_HEADS) * jax.nn.silu(hg)
        h = h + jnp.concatenate([a_out, r_out], axis=-1) @ w_out[i]
        u = rmsnorm(h, ffn_norm_gain[i])
        j = i // 2
        if i % 2 == 0:
            h = h + swiglu(u, w_ffn_gate[j], w_ffn_up[j], w_ffn_down[j])
        else:
            h = h + moe_swiglu(u, w_router[j], w_exp_gate[j], w_exp_up[j], w_exp_down[j])
        u = rmsnorm(h, ple_norm_gain[i])
        h = h + (p[i] @ w_ple[i]) * jax.nn.sigmoid(u @ w_ple_gate[i])
    return rmsnorm(h, final_norm_gain)
```

```cpp
#include <hip/hip_runtime.h>
#include <cstdio>
#include <cstdint>

namespace v0 {
constexpr int D = 1024, BATCH = 8, SEQ = 2048, DEPTH = 4, DPLE = 256, HD = 64;
constexpr int FW = 512, FH = 8, HW = 512, HH = 8;
constexpr int DIN = 3592, DFF = 2816, NE = 8, DEXP = 3584;
constexpr int M = BATCH * SEQ;
constexpr float EPS = 1e-6f;
constexpr int ZQ = 0, ZK = 512, ZV = 1024, ZG = 1536, ZHQ = 1544, ZHF = 2056, ZHI = 2568, ZHG = 3080;

__device__ __forceinline__ float wave_sum(float v) {
#pragma unroll
    for (int o = 1; o < 64; o <<= 1) v += __shfl_xor(v, o);
    return v;
}
__device__ __forceinline__ float sigmoidf_(float x) { return 1.f / (1.f + __expf(-x)); }
__device__ __forceinline__ float log_sigmoid(float x) { return fminf(x, 0.f) - log1pf(__expf(-fabsf(x))); }

__global__ void k_lb(const float* __restrict__ logits, float* __restrict__ lb) {
    int c = blockIdx.x * blockDim.x + threadIdx.x; if (c >= HW) return;
    float l[DEPTH], mx = -1e30f;
    for (int i = 0; i < DEPTH; ++i) { l[i] = logits[i * HW + c]; mx = fmaxf(mx, l[i]); }
    float s = 0.f; for (int i = 0; i < DEPTH; ++i) { l[i] = __expf(l[i] - mx); s += l[i]; }
    float cum = 0.f;
    for (int i = 0; i < DEPTH; ++i) { lb[i * HW + c] = cum; if (i + 1 < DEPTH) cum += l[i + 1] / s; }
}

__global__ void k_rmsnorm(const float* __restrict__ x, const float* __restrict__ gain, float* __restrict__ out, int rows) {
    int row = blockIdx.x * (blockDim.x / 64) + (threadIdx.x >> 6), lane = threadIdx.x & 63; if (row >= rows) return;
    const float4* xr = (const float4*)(x + (size_t)row * D); float4 v[4]; float s = 0.f;
#pragma unroll
    for (int j = 0; j < 4; ++j) { v[j] = xr[lane + 64 * j]; s += v[j].x * v[j].x + v[j].y * v[j].y + v[j].z * v[j].z + v[j].w * v[j].w; }
    s = wave_sum(s); float r = rsqrtf(s / D + EPS);
    float4* o = (float4*)(out + (size_t)row * D); const float4* g = (const float4*)gain;
#pragma unroll
    for (int j = 0; j < 4; ++j) { float4 gg = g[lane + 64 * j]; o[lane + 64 * j] = make_float4(v[j].x * r * gg.x, v[j].y * r * gg.y, v[j].z * r * gg.z, v[j].w * r * gg.w); }
}

struct GemmP {
    const float* A; int lda; const int* rowidx;
    const float* B; const float* B2; int ldb; size_t strideB;
    float* C; int ldc; int Mstat; const int* cnt; const int* base;
    int N, K;
};
template <int MODE> __global__ void __launch_bounds__(256) k_gemm(GemmP p) {
    __shared__ float As[8][128 + 4]; __shared__ float Bs[8][128]; __shared__ float Bs2[MODE == 2 ? 8 : 1][128];
    const int z = blockIdx.z; const int Mz = p.cnt ? p.cnt[z] : p.Mstat; const int rbase = p.cnt ? p.base[z] : 0;
    const int m0 = blockIdx.y * 128, n0 = blockIdx.x * 128; if (m0 >= Mz) return;
    const float* B = p.B + (size_t)z * p.strideB; const float* B2 = MODE == 2 ? p.B2 + (size_t)z * p.strideB : nullptr;
    const int tid = threadIdx.x, ty = tid / 16, tx = tid % 16;
    float acc[8][8]; float acc2[MODE == 2 ? 8 : 1][8];
#pragma unroll
    for (int i = 0; i < 8; ++i)
#pragma unroll
        for (int j = 0; j < 8; ++j) { acc[i][j] = 0.f; if (MODE == 2) acc2[i][j] = 0.f; }
    const int ar = tid / 2, ak = (tid % 2) * 4; const bool aok = (m0 + ar) < Mz;
    size_t arow = 0; if (aok) { int r = rbase + m0 + ar; arow = (size_t)(p.rowidx ? p.rowidx[r] : r); }
    const float* Ap = p.A + arow * p.lda + ak;
    const int bk = tid / 32, bc = (tid % 32) * 4; const bool bok = (n0 + bc) < p.N;
    for (int k0 = 0; k0 < p.K; k0 += 8) {
        float4 av = aok ? *(const float4*)(Ap + k0) : make_float4(0, 0, 0, 0);
        float4 bv = bok ? *(const float4*)(B + (size_t)(k0 + bk) * p.ldb + n0 + bc) : make_float4(0, 0, 0, 0);
        float4 bv2 = make_float4(0, 0, 0, 0); if (MODE == 2 && bok) bv2 = *(const float4*)(B2 + (size_t)(k0 + bk) * p.ldb + n0 + bc);
        __syncthreads();
        As[ak + 0][ar] = av.x; As[ak + 1][ar] = av.y; As[ak + 2][ar] = av.z; As[ak + 3][ar] = av.w;
        *(float4*)&Bs[bk][bc] = bv; if (MODE == 2) *(float4*)&Bs2[bk][bc] = bv2;
        __syncthreads();
#pragma unroll
        for (int kk = 0; kk < 8; ++kk) {
            float a[8], b[8];
            *(float4*)&a[0] = *(const float4*)&As[kk][ty * 4]; *(float4*)&a[4] = *(const float4*)&As[kk][64 + ty * 4];
            *(float4*)&b[0] = *(const float4*)&Bs[kk][tx * 4]; *(float4*)&b[4] = *(const float4*)&Bs[kk][64 + tx * 4];
#pragma unroll
            for (int i = 0; i < 8; ++i)
#pragma unroll
                for (int j = 0; j < 8; ++j) acc[i][j] += a[i] * b[j];
            if (MODE == 2) {
                float b2[8]; *(float4*)&b2[0] = *(const float4*)&Bs2[kk][tx * 4]; *(float4*)&b2[4] = *(const float4*)&Bs2[kk][64 + tx * 4];
#pragma unroll
                for (int i = 0; i < 8; ++i)
#pragma unroll
                    for (int j = 0; j < 8; ++j) acc2[i][j] += a[i] * b2[j];
            }
        }
    }
#pragma unroll
    for (int i = 0; i < 8; ++i) {
        const int r = m0 + (i < 4 ? ty * 4 + i : 64 + ty * 4 + i - 4); if (r >= Mz) continue;
        float* Cr = p.C + (size_t)(rbase + r) * p.ldc;
#pragma unroll
        for (int j = 0; j < 8; ++j) {
            const int c = n0 + (j < 4 ? tx * 4 + j : 64 + tx * 4 + j - 4); if (c >= p.N) continue;
            float v = acc[i][j];
            if (MODE == 1) v += Cr[c];
            if (MODE == 2) { float g = v; v = g * sigmoidf_(g) * acc2[i][j]; }
            Cr[c] = v;
        }
    }
}

__global__ void k_fox_c(const float* __restrict__ z, const float* __restrict__ bias, float* __restrict__ c) {
    const int bh = blockIdx.x, b = bh / FH, h = bh % FH, lane = threadIdx.x;
    const float bi = bias[h]; float loc[32]; float s = 0.f;
#pragma unroll
    for (int j = 0; j < 32; ++j) { int t = lane * 32 + j; s += log_sigmoid(z[(size_t)(b * SEQ + t) * DIN + ZG + h] + bi); loc[j] = s; }
    float incl = s;
#pragma unroll
    for (int o = 1; o < 64; o <<= 1) { float n = __shfl_up(incl, o); if (lane >= o) incl += n; }
    const float excl = incl - s;
#pragma unroll
    for (int j = 0; j < 32; ++j) c[(size_t)bh * SEQ + lane * 32 + j] = excl + loc[j];
}

__global__ void __launch_bounds__(256) k_fox_attn(const float* __restrict__ z, const float* __restrict__ c, float* __restrict__ out) {
    __shared__ float Ks[64][64]; __shared__ float Vs[64][64]; __shared__ float Cs[64];
    const int qb = blockIdx.x, bh = blockIdx.y, b = bh / FH, h = bh % FH, tid = threadIdx.x;
    const int qi = qb * 256 + tid; const size_t rowq = (size_t)(b * SEQ + qi);
    float q[64], o[64];
#pragma unroll
    for (int d = 0; d < 64; d += 4) { float4 v = *(const float4*)(z + rowq * DIN + ZQ + h * HD + d); q[d] = v.x * 0.125f; q[d + 1] = v.y * 0.125f; q[d + 2] = v.z * 0.125f; q[d + 3] = v.w * 0.125f; }
#pragma unroll
    for (int d = 0; d < 64; ++d) o[d] = 0.f;
    const float cq = c[(size_t)bh * SEQ + qi]; float mx = -1e30f, l = 0.f;
    const int ntile = (qb * 256 + 256) / 64;
    for (int kt = 0; kt < ntile; ++kt) {
        __syncthreads();
        for (int e = tid; e < 64 * 16; e += 256) { int r = e / 16, c4 = (e % 16) * 4; const size_t rk = (size_t)(b * SEQ + kt * 64 + r);
            *(float4*)&Ks[r][c4] = *(const float4*)(z + rk * DIN + ZK + h * HD + c4); *(float4*)&Vs[r][c4] = *(const float4*)(z + rk * DIN + ZV + h * HD + c4); }
        if (tid < 64) Cs[tid] = c[(size_t)bh * SEQ + kt * 64 + tid];
        __syncthreads();
        for (int j = 0; j < 64; ++j) {
            const int kj = kt * 64 + j; if (kj > qi) break;
            float s = 0.f;
#pragma unroll
            for (int d = 0; d < 64; ++d) s += q[d] * Ks[j][d];
            s += cq - Cs[j];
            if (s > mx) { const float f = __expf(mx - s); l *= f;
#pragma unroll
                for (int d = 0; d < 64; ++d) o[d] *= f;
                mx = s; }
            const float pw = __expf(s - mx); l += pw;
#pragma unroll
            for (int d = 0; d < 64; ++d) o[d] += pw * Vs[j][d];
        }
    }
    const float il = 1.f / l;
#pragma unroll
    for (int d = 0; d < 64; d += 4) *(float4*)(out + rowq * FW + h * HD + d) = make_float4(o[d] * il, o[d + 1] * il, o[d + 2] * il, o[d + 3] * il);
}

__global__ void k_hgrn_fk(const float* __restrict__ z, const float* __restrict__ lb, float* __restrict__ F, float* __restrict__ KK) {
    size_t i = (size_t)blockIdx.x * blockDim.x + threadIdx.x; if (i >= (size_t)M * HW) return;
    const int cidx = (int)(i % HW); const size_t row = i / HW;
    const float l = lb[cidx]; const float f = l + (1.f - l) * sigmoidf_(z[row * DIN + ZHF + cidx]);
    F[i] = f; KK[i] = 1.f - f;
}
__global__ void __launch_bounds__(64) k_hgrn_rec(const float* __restrict__ z, const float* __restrict__ F, const float* __restrict__ KK, float* __restrict__ out) {
    const int bh = blockIdx.x, b = bh / HH, h = bh % HH, v = threadIdx.x;
    float S[64];
#pragma unroll
    for (int d = 0; d < 64; ++d) S[d] = 0.f;
    for (int t = 0; t < SEQ; ++t) {
        const size_t row = (size_t)(b * SEQ + t);
        const float* f = F + row * HW + h * HD; const float* k = KK + row * HW + h * HD; const float* q = z + row * DIN + ZHQ + h * HD;
        const float vi = z[row * DIN + ZHI + h * HD + v]; float o = 0.f;
#pragma unroll
        for (int d = 0; d < 64; ++d) { S[d] = f[d] * S[d] + k[d] * vi; o += S[d] * q[d]; }
        out[row * HW + h * HD + v] = o;
    }
}
__global__ void k_mix(const float* __restrict__ att, const float* __restrict__ hgo, const float* __restrict__ z, const float* __restrict__ fgain, const float* __restrict__ hgain, float* __restrict__ mix) {
    size_t i = (size_t)blockIdx.x * blockDim.x + threadIdx.x; if (i >= (size_t)M * 16) return;
    const size_t row = i / 16; const int hh = (int)(i % 16);
    const bool fox = hh < 8; const int h = fox ? hh : hh - 8;
    const float* src = (fox ? att : hgo) + row * 512 + h * HD; const float* g = (fox ? fgain : hgain) + h * HD;
    float s = 0.f; for (int d = 0; d < 64; ++d) s += src[d] * src[d];
    const float r = rsqrtf(s / 64.f + EPS);
    float* dst = mix + row * D + hh * HD;
    for (int d = 0; d < 64; ++d) { float v = src[d] * r * g[d]; if (!fox) { const float gg = z[row * DIN + ZHG + h * HD + d]; v *= gg * sigmoidf_(gg); } dst[d] = v; }
}
__global__ void k_ple(float* __restrict__ h, const float* __restrict__ P2, const float* __restrict__ G, size_t n) {
    size_t i = (size_t)blockIdx.x * blockDim.x + threadIdx.x; if (i >= n) return; h[i] += P2[i] * sigmoidf_(G[i]);
}
__global__ void k_router(const float* __restrict__ u, const float* __restrict__ wr, int* __restrict__ tok_e, float* __restrict__ tok_w, int* __restrict__ cnt) {
    const int row = blockIdx.x * (blockDim.x / 64) + (threadIdx.x >> 6), lane = threadIdx.x & 63; if (row >= M) return;
    float acc[NE];
#pragma unroll
    for (int e = 0; e < NE; ++e) acc[e] = 0.f;
    for (int k = lane; k < D; k += 64) { const float x = u[(size_t)row * D + k]; const float4 w0 = *(const float4*)(wr + k * NE), w1 = *(const float4*)(wr + k * NE + 4);
        acc[0] += x * w0.x; acc[1] += x * w0.y; acc[2] += x * w0.z; acc[3] += x * w0.w; acc[4] += x * w1.x; acc[5] += x * w1.y; acc[6] += x * w1.z; acc[7] += x * w1.w; }
#pragma unroll
    for (int e = 0; e < NE; ++e) acc[e] = wave_sum(acc[e]);
    if (lane == 0) {
        int i0 = 0; for (int e = 1; e < NE; ++e) if (acc[e] > acc[i0]) i0 = e;
        int i1 = (i0 == 0) ? 1 : 0; for (int e = 0; e < NE; ++e) if (e != i0 && acc[e] > acc[i1]) i1 = e;
        const float e1 = __expf(acc[i1] - acc[i0]); const float w0 = 1.f / (1.f + e1), w1 = e1 / (1.f + e1);
        tok_e[row * 2] = i0; tok_e[row * 2 + 1] = i1; tok_w[row * 2] = w0; tok_w[row * 2 + 1] = w1;
        atomicAdd(&cnt[i0], 1); atomicAdd(&cnt[i1], 1);
    }
}
__global__ void k_moe_base(const int* __restrict__ cnt, int* __restrict__ base) { if (threadIdx.x == 0) { int s = 0; for (int e = 0; e < NE; ++e) { base[e] = s; s += cnt[e]; } } }
__global__ void k_moe_assign(const int* __restrict__ tok_e, const int* __restrict__ base, int* __restrict__ fill, int* __restrict__ list, int* __restrict__ slot_of) {
    const int i = blockIdx.x * blockDim.x + threadIdx.x; if (i >= M * 2) return;
    const int e = tok_e[i]; const int s = base[e] + atomicAdd(&fill[e], 1); list[s] = i / 2; slot_of[i] = s;
}
__global__ void k_moe_combine(float* __restrict__ h, const float* __restrict__ Y, const int* __restrict__ slot_of, const float* __restrict__ tok_w) {
    size_t i = (size_t)blockIdx.x * blockDim.x + threadIdx.x; if (i >= (size_t)M * D) return;
    const size_t row = i / D; const int c = (int)(i % D);
    h[i] += tok_w[row * 2] * Y[(size_t)slot_of[row * 2] * D + c] + tok_w[row * 2 + 1] * Y[(size_t)slot_of[row * 2 + 1] * D + c];
}
}

extern "C" void kernel_launch(void* const* d_in, const int* in_sizes, int n_in, void* d_out, int out_size, void* d_ws, size_t ws_size, hipStream_t stream) {
    using namespace v0;
    const float* x = (const float*)d_in[0]; const float* p = (const float*)d_in[1]; const float* w_in = (const float*)d_in[2];
    const float* fox_bias = (const float*)d_in[3]; const float* fox_gain = (const float*)d_in[4]; const float* lb_logits = (const float*)d_in[5];
    const float* hgrn_gain = (const float*)d_in[6]; const float* w_out = (const float*)d_in[7]; const float* mix_gain = (const float*)d_in[8];
    const float* ffn_gain = (const float*)d_in[9]; const float* ple_gain = (const float*)d_in[10]; const float* w_fg = (const float*)d_in[11];
    const float* w_fu = (const float*)d_in[12]; const float* w_fd = (const float*)d_in[13]; const float* w_router = (const float*)d_in[14];
    const float* w_eg = (const float*)d_in[15]; const float* w_eu = (const float*)d_in[16]; const float* w_ed = (const float*)d_in[17];
    const float* w_ple = (const float*)d_in[18]; const float* w_pg = (const float*)d_in[19]; const float* fin_gain = (const float*)d_in[20];
    float* out = (float*)d_out;
    float* ws = (float*)d_ws; size_t off = 0;
    auto take = [&](size_t n) { float* r = ws + off; off += (n + 63) & ~(size_t)63; return r; };
    int* ictl = (int*)take(4096);
    float* lb = take(DEPTH * HW);
    float* h = take((size_t)M * D); float* u = take((size_t)M * D);
    int* tok_e = (int*)take((size_t)M * 2); float* tok_w = take((size_t)M * 2); int* list = (int*)take((size_t)M * 2); int* slot_of = (int*)take((size_t)M * 2);
    float* cbuf = take((size_t)BATCH * FH * SEQ);
    const size_t R2 = off;
    float* z = take((size_t)M * DIN); float* att = take((size_t)M * FW); float* hgo = take((size_t)M * HW); float* mix = take((size_t)M * D);
    float* Fb = take((size_t)M * HW); float* KKb = take((size_t)M * HW);
    off = R2; float* act = take((size_t)M * DFF);
    off = R2; float* Hg = take((size_t)2 * M * DEXP); float* Y = take((size_t)2 * M * D);
    const size_t need = off * 4;
    off = R2; float* G = take((size_t)M * D); float* P2 = take((size_t)M * D);
    if (need > ws_size) { fprintf(stderr, "workspace too small: need %zu have %zu\n", need, ws_size); return; }

    hipMemcpyAsync(h, x, (size_t)M * D * 4, hipMemcpyDeviceToDevice, stream);
    k_lb<<<2, 256, 0, stream>>>(lb_logits, lb);
    for (int i = 0; i < DEPTH; ++i) {
        k_rmsnorm<<<M / 4, 256, 0, stream>>>(h, mix_gain + i * D, u, M);
        { GemmP g{}; g.A = u; g.lda = D; g.B = w_in + (size_t)i * D * DIN; g.ldb = DIN; g.C = z; g.ldc = DIN; g.Mstat = M; g.N = DIN; g.K = D;
          k_gemm<0><<<dim3((DIN + 127) / 128, M / 128, 1), 256, 0, stream>>>(g); }
        k_fox_c<<<BATCH * FH, 64, 0, stream>>>(z, fox_bias + i * FH, cbuf);
        k_fox_attn<<<dim3(SEQ / 256, BATCH * FH), 256, 0, stream>>>(z, cbuf, att);
        k_hgrn_fk<<<(M * HW + 255) / 256, 256, 0, stream>>>(z, lb + i * HW, Fb, KKb);
        k_hgrn_rec<<<BATCH * HH, 64, 0, stream>>>(z, Fb, KKb, hgo);
        k_mix<<<(M * 16 + 255) / 256, 256, 0, stream>>>(att, hgo, z, fox_gain + i * FW, hgrn_gain + i * HW, mix);
        { GemmP g{}; g.A = mix; g.lda = D; g.B = w_out + (size_t)i * D * D; g.ldb = D; g.C = h; g.ldc = D; g.Mstat = M; g.N = D; g.K = D;
          k_gemm<1><<<dim3(D / 128, M / 128, 1), 256, 0, stream>>>(g); }
        k_rmsnorm<<<M / 4, 256, 0, stream>>>(h, ffn_gain + i * D, u, M);
        const int j = i / 2;
        if (i % 2 == 0) {
            { GemmP g{}; g.A = u; g.lda = D; g.B = w_fg + (size_t)j * D * DFF; g.B2 = w_fu + (size_t)j * D * DFF; g.ldb = DFF; g.C = act; g.ldc = DFF; g.Mstat = M; g.N = DFF; g.K = D;
              k_gemm<2><<<dim3(DFF / 128, M / 128, 1), 256, 0, stream>>>(g); }
            { GemmP g{}; g.A = act; g.lda = DFF; g.B = w_fd + (size_t)j * DFF * D; g.ldb = D; g.C = h; g.ldc = D; g.Mstat = M; g.N = D; g.K = DFF;
              k_gemm<1><<<dim3(D / 128, M / 128, 1), 256, 0, stream>>>(g); }
        } else {
            hipMemsetAsync(ictl, 0, 4096 * 4, stream);
            k_router<<<M / 4, 256, 0, stream>>>(u, w_router + (size_t)j * D * NE, tok_e, tok_w, ictl);
            k_moe_base<<<1, 64, 0, stream>>>(ictl, ictl + 64);
            k_moe_assign<<<(M * 2 + 255) / 256, 256, 0, stream>>>(tok_e, ictl + 64, ictl + 128, list, slot_of);
            { GemmP g{}; g.A = u; g.lda = D; g.rowidx = list; g.B = w_eg + (size_t)j * NE * D * DEXP; g.B2 = w_eu + (size_t)j * NE * D * DEXP; g.ldb = DEXP; g.strideB = (size_t)D * DEXP;
              g.C = Hg; g.ldc = DEXP; g.cnt = ictl; g.base = ictl + 64; g.N = DEXP; g.K = D;
              k_gemm<2><<<dim3(DEXP / 128, M / 128, NE), 256, 0, stream>>>(g); }
            { GemmP g{}; g.A = Hg; g.lda = DEXP; g.B = w_ed + (size_t)j * NE * DEXP * D; g.ldb = D; g.strideB = (size_t)DEXP * D;
              g.C = Y; g.ldc = D; g.cnt = ictl; g.base = ictl + 64; g.N = D; g.K = DEXP;
              k_gemm<0><<<dim3(D / 128, M / 128, NE), 256, 0, stream>>>(g); }
            k_moe_combine<<<(int)(((size_t)M * D + 255) / 256), 256, 0, stream>>>(h, Y, slot_of, tok_w);
        }
        k_rmsnorm<<<M / 4, 256, 0, stream>>>(h, ple_gain + i * D, u, M);
        { GemmP g{}; g.A = u; g.lda = D; g.B = w_pg + (size_t)i * D * D; g.ldb = D; g.C = G; g.ldc = D; g.Mstat = M; g.N = D; g.K = D;
          k_gemm<0><<<dim3(D / 128, M / 128, 1), 256, 0, stream>>>(g); }
        { GemmP g{}; g.A = p + (size_t)i * M * DPLE; g.lda = DPLE; g.B = w_ple + (size_t)i * DPLE * D; g.ldb = D; g.C = P2; g.ldc = D; g.Mstat = M; g.N = D; g.K = DPLE;
          k_gemm<0><<<dim3(D / 128, M / 128, 1), 256, 0, stream>>>(g); }
        k_ple<<<(int)(((size_t)M * D + 255) / 256), 256, 0, stream>>>(h, P2, G, (size_t)M * D);
    }
    k_rmsnorm<<<M / 4, 256, 0, stream>>>(h, fin_gain, out, M);
}
```

```cpp
#include <hip/hip_runtime.h>
#include <cstdio>
#include <cstdint>
#define MK_NAIVE_ATTN 0
#define MK_NAIVE_HGRN 0
#define MK_ONE_LAUNCH 1
#define MK_PROBE 0
#define MK_FP8_LAST 1
#define MK_FP8_L1 1
#define MK_FP8_DENSE 2
#define MK_TOUCH 0
#define MK_MOE_WGM 8
#define MK_RES_TOUCH 0
#define MK_RELAX_WAIT 0
#define MK_Q_IN 4500
#define MK_Q_IN8 2800
#define MK_Q_UP 9000
#define MK_Q_UP8 5600
#define MK_Q_SC 1920
#define MK_QB 1536
#define MK_MFMA_NOSCALE 1
#define MK_NT 1
#define MK_PKZERO 1
#define MK_LT16 1
#define MK_F8_ORDER 1
#define MK_WGM 4
#define MK_FP8_IN 8
#define F8IN(i) (MK_FP8_IN != 0 && ((MK_FP8_IN >> (i)) & 1))
#define F8DENSE(j) (MK_FP8_DENSE == 3 || (MK_FP8_DENSE != 0 && ((MK_FP8_DENSE >> (j)) & 1)))
namespace pg8 {
#define PG8_LAS __attribute__((address_space(3)))
typedef unsigned short bf16_t;
typedef short bf16x8 __attribute__((ext_vector_type(8)));
typedef float f32x4 __attribute__((ext_vector_type(4)));
typedef unsigned u32x4 __attribute__((ext_vector_type(4)));
constexpr int BM = 256, BK = 64, HALF = 128, HTB = HALF * BK * 2  , STAGE_BYTES = 8 * HTB, NXCD = 8, WGM = MK_WGM;

__host__ __device__ __forceinline__ int lds_byte(int r, int c) { const int st = (r >> 4) * 2 + (c >> 5), rr = r & 15, cc = c & 31, ob = rr * 64 + cc * 2; return st * 1024 + (ob ^ (((ob >> 9) & 1) << 5)); }
__host__ __device__ __forceinline__ void stage_rc(int b, int& R, int& C) { const int st = b / 1024, sb = b % 1024, swz = sb ^ (((sb >> 9) & 1) << 5); R = (st >> 1) * 16 + swz / 64; C = (st & 1) * 32 + (swz % 64) / 2; }
__host__ __device__ __forceinline__ int perm32(int rho) { const int n = rho >> 4, i = rho & 15; return 8 * (i >> 2) + 4 * n + (i & 3); }

__device__ __forceinline__ int pg8_lane_volatile() { int l; asm volatile("v_mbcnt_lo_u32_b32 %0, -1, 0\n\tv_mbcnt_hi_u32_b32 %0, -1, %0" : "=v"(l)); return l; }
struct Unit { int pm, pn, pb, koff, tag; };
struct Gemm { const bf16_t* A; const bf16_t* Bt; int M, N, K, ld; };

struct StaticOrder {
    int nM, nN, nwg, G, c;
    __host__ __device__ void init(int M, int N, int G_, int c_) { nM = M / BM; nN = N / BM; nwg = nM * nN; G = G_; c = c_; }
    __host__ __device__ bool next(int i, Unit& u) const {
        const long L = (long)i * G + c; if (L >= nwg) return false;
        int wgid = (int)L; { const int q = nwg / NXCD, r = nwg % NXCD, xcd = wgid % NXCD, off = wgid / NXCD; wgid = (xcd < r ? xcd * (q + 1) : r * (q + 1) + (xcd - r) * q) + off; }
        const int nig = WGM * nN, gid = wgid / nig, fm = gid * WGM, gsz = (nM - fm) < WGM ? (nM - fm) : WGM;
        u.pm = fm + ((wgid % nig) % gsz); u.pn = (wgid % nig) / gsz; u.pb = u.pn; u.koff = 0; u.tag = 0; return true;
    }
    __device__ __forceinline__ void a_ready(const Unit&) const {}
    __device__ __forceinline__ void done(const Unit&) const {}
};

__device__ __forceinline__ unsigned cvt_pk_bf16(float lo, float hi) { unsigned r; asm volatile("v_cvt_pk_bf16_f32 %0, %1, %2" : "=v"(r) : "v"(lo), "v"(hi)); return r; }
typedef float f32x2 __attribute__((ext_vector_type(2)));
typedef int i32x4_t __attribute__((ext_vector_type(4)));
template <class Epi, class Sched, bool ALIGN_EPI = false, bool SP2 = false, bool F8 = false>
__device__ __forceinline__ void gemm_phase(PG8_LAS unsigned char* lds, const Gemm g, const Sched& S, const Epi& E, const int tid_in) {
    int tid_o = tid_in; asm volatile("" : "+v"(tid_o));
    const int tid = tid_o, wid = __builtin_amdgcn_readfirstlane(tid >> 6), lane = tid & 63, wr = wid >> 2, wc = wid & 3, fr = lane & 15, fq = lane >> 4;
    const int K = g.ld, nt = g.K / BK;
    unsigned voffA[1], voffB[1];
    { int R, C; stage_rc(tid * 16, R, C); const int Rb = Epi::PERM ? ((R & ~31) + perm32(R & 31)) : R;
      voffA[0] = (unsigned)(R * K + C) * 2u; voffB[0] = (unsigned)(Rb * K + C) * 2u; }
    const size_t rstep64 = (size_t)64 * K * 2;
    const size_t kstep = (size_t)(BK * 2);
    const size_t hstep = (size_t)HALF * K * 2;
    const size_t tstep = 2 * hstep;
    const unsigned ldsw = (unsigned)wid * 1024u;
    const int aoff = lds_byte(wr * 64 + fr, fq * 8), boff = lds_byte(wc * 32 + fr, fq * 8);
#define PG8_SA(b, h) (((b) * 2 + (h)) * HTB)
#define PG8_SB(b, h) ((4 + (b) * 2 + (h)) * HTB)
#define PG8_STAGE(bufoff, gbase, voff) do { _Pragma("unroll") for (int _i = 0; _i < 2; ++_i)   \
        __builtin_amdgcn_global_load_lds((const unsigned*)((const char*)(gbase) + (size_t)_i * rstep64 + (voff)[0]), (PG8_LAS unsigned*)(lds + (bufoff) + ldsw + _i * 8192), 16, 0, 0); } while (0)
#define PG8_LDA(dst, b, h) do { _Pragma("unroll") for (int m = 0; m < 4; ++m) _Pragma("unroll") for (int k = 0; k < 2; ++k) dst[m][k] = *(const PG8_LAS bf16x8*)(lds + PG8_SA(b, h) + aoff + m * 2048 + k * 1024); } while (0)
#define PG8_LDB(dst, b, h) do { _Pragma("unroll") for (int n = 0; n < 2; ++n) _Pragma("unroll") for (int k = 0; k < 2; ++k) dst[n][k] = *(const PG8_LAS bf16x8*)(lds + PG8_SB(b, h) + boff + n * 2048 + k * 1024); } while (0)
#define PG8_CAT8(lo, hi) __builtin_shufflevector(__builtin_bit_cast(i32x4_t, lo), __builtin_bit_cast(i32x4_t, hi), 0, 1, 2, 3, 4, 5, 6, 7)
#define PG8_MMA(ai, bj, At, Bt) do { __builtin_amdgcn_s_setprio(1); \
        if constexpr (F8) {   \
            _Pragma("unroll") for (int mm_ = 0; mm_ < 8; ++mm_) { const int n = MK_F8_ORDER ? (mm_ & 1) : (mm_ >> 2), m = MK_F8_ORDER ? (mm_ >> 1) : (mm_ & 3); { const auto b8_ = PG8_CAT8(Bt[n][0], Bt[n][1]); const auto a8_ = PG8_CAT8(At[m][0], At[m][1]);   \
                    if constexpr (MK_MFMA_NOSCALE) asm volatile("v_mfma_f32_16x16x128_f8f6f4 %0, %1, %2, %0" : "+v"(acc[ai][bj][m][n]) : "v"(b8_), "v"(a8_));   \
                    else asm volatile("v_mfma_scale_f32_16x16x128_f8f6f4 %0, %1, %2, %0, %3, %3 op_sel_hi:[0,0,0]" : "+v"(acc[ai][bj][m][n]) : "v"(b8_), "v"(a8_), "v"(f8one)); } } } \
        else { _Pragma("unroll") for (int m = 0; m < 4; ++m) _Pragma("unroll") for (int n = 0; n < 2; ++n) _Pragma("unroll") for (int k = 0; k < 2; ++k) \
            acc[ai][bj][m][n] = __builtin_amdgcn_mfma_f32_16x16x32_bf16(Bt[n][k], At[m][k], acc[ai][bj][m][n], 0, 0, 0); } \
        __builtin_amdgcn_s_setprio(0); } while (0)
#define PG8_WAIT_V(n) asm volatile("s_waitcnt vmcnt(" #n ")" ::: "memory")
#define PG8_WAIT_L(n) asm volatile("s_waitcnt lgkmcnt(" #n ")" ::: "memory")
#define PG8_WAIT_VN(n) asm volatile("s_waitcnt vmcnt(%0)" :: "n"(n) : "memory")
#define PG8_BAR __builtin_amdgcn_s_barrier()
#define PG8_SCHED __builtin_amdgcn_sched_barrier(0)
    Unit cur, nxt; int ui = 0; bool epi_stores = false;
    if (!S.next(0, cur)) return;
    int f8one = 0x7f7f7f7f; if constexpr (F8) asm volatile("" : "+v"(f8one));
    typedef float f32x2z __attribute__((ext_vector_type(2)));
    f32x2z zz2 = {0.f, 0.f}; asm volatile("" : "+v"(zz2));
    f32x4 acc[2][2][4][2];
#pragma unroll
    for (int a = 0; a < 2; ++a)
#pragma unroll
        for (int b = 0; b < 2; ++b)
#pragma unroll
            for (int m = 0; m < 4; ++m)
#pragma unroll
                for (int n = 0; n < 2; ++n) { if constexpr (MK_PKZERO) acc[a][b][m][n] = __builtin_shufflevector(zz2, zz2, 0, 1, 0, 1);
                    else { float z_ = 0.f; if constexpr (F8) asm volatile("" : "+v"(z_)); acc[a][b][m][n] = (f32x4){z_, z_, z_, z_}; } }
    bf16x8 At[4][2], B0[2][2], B1[2][2];
    const char* cA = (const char*)g.A + (size_t)cur.pm * tstep + (size_t)cur.koff * 2; const char* cB = (const char*)g.Bt + (size_t)cur.pb * tstep + (size_t)cur.koff * 2;
    S.a_ready(cur);
    PG8_LAS float* const rtab = (PG8_LAS float*)(lds + STAGE_BYTES + 2048);
    bool pre_all = false;
    if constexpr (Epi::HAS_PREP) { Unit uu; pre_all = !S.next(8, uu);
        if (pre_all) { for (int i = 0; i < 8 && S.next(i, uu); ++i) E.prep(rtab + i * 256, uu, tid); }
        else E.prep(rtab, cur, tid); }
#if MK_RES_TOUCH
    if constexpr (Epi::TOUCH) {
        const char* rb = (const char*)E.hb + ((size_t)cur.pm * BM * 1024 + (size_t)cur.pn * BM) * 2;
#pragma unroll
        for (int i = 0; i < 4; ++i) { const int idx = i * 512 + tid; __builtin_amdgcn_global_load_lds((const unsigned*)(rb + (size_t)(idx >> 3) * 2048 + (idx & 7) * 64), (PG8_LAS unsigned*)(lds + STAGE_BYTES + 12288 + wid * 256), 4, 0, 0); }
    }
#endif
    if constexpr (SP2) {
        PG8_STAGE(PG8_SB(0, 0), cB, voffB); PG8_STAGE(PG8_SB(0, 1), cB + hstep, voffB); PG8_STAGE(PG8_SA(0, 0), cA, voffA); PG8_STAGE(PG8_SA(0, 1), cA + hstep, voffA);
        if (wr == 1) PG8_BAR;
        PG8_WAIT_V(2); PG8_BAR;
        PG8_STAGE(PG8_SB(1, 0), cB + kstep, voffB); PG8_STAGE(PG8_SA(1, 0), cA + kstep, voffA); PG8_STAGE(PG8_SB(1, 1), cB + hstep + kstep, voffB);
        PG8_WAIT_V(6); PG8_BAR;
    } else {
        PG8_STAGE(PG8_SB(0, 0), cB, voffB); PG8_STAGE(PG8_SA(0, 0), cA, voffA); PG8_STAGE(PG8_SB(0, 1), cB + hstep, voffB); PG8_STAGE(PG8_SA(0, 1), cA + hstep, voffA);
        if (wr == 1) PG8_BAR;
        PG8_WAIT_V(4); PG8_BAR;
        PG8_STAGE(PG8_SB(1, 0), cB + kstep, voffB); PG8_STAGE(PG8_SA(1, 0), cA + kstep, voffA); PG8_STAGE(PG8_SB(1, 1), cB + hstep + kstep, voffB);
        PG8_WAIT_V(6); PG8_BAR;
    }
    for (;;) {
        const bool has_next = S.next(ui + 1, nxt);
        const char* nA = has_next ? (const char*)g.A + (size_t)nxt.pm * tstep + (size_t)nxt.koff * 2 : cA; const char* nB = has_next ? (const char*)g.Bt + (size_t)nxt.pb * tstep + (size_t)nxt.koff * 2 : cB;
#pragma unroll 1
        for (int t = 0; t < nt; t += 2) {
            const bool last = (t == nt - 2);
            const char* a1 = cA + (size_t)(t + 1) * kstep;
            const char* a2 = last ? nA : cA + (size_t)(t + 2) * kstep; const char* b2 = last ? nB : cB + (size_t)(t + 2) * kstep;
            const char* a3 = a2 + kstep; const char* b3 = b2 + kstep;
            if (last && has_next) S.a_ready(nxt);
            if constexpr (SP2) {
            const bool rlx = MK_RELAX_WAIT && Epi::NST > 0 && t == 0 && epi_stores;
            PG8_LDB(B0, 0, 0); PG8_LDB(B1, 0, 1); PG8_SCHED; PG8_LDA(At, 0, 0); PG8_STAGE(PG8_SA(1, 1), a1 + hstep, voffA);
            if (rlx) PG8_WAIT_VN(8 + Epi::NST); else PG8_WAIT_V(8);
            PG8_WAIT_L(0); PG8_BAR; PG8_MMA(0, 0, At, B0); PG8_MMA(0, 1, At, B1); PG8_BAR; PG8_SCHED;
            PG8_LDA(At, 0, 1); PG8_STAGE(PG8_SB(0, 0), b2, voffB); PG8_STAGE(PG8_SB(0, 1), b2 + hstep, voffB); PG8_STAGE(PG8_SA(0, 0), a2, voffA);
            if (rlx) PG8_WAIT_VN(8 + Epi::NST); else PG8_WAIT_V(8);
            PG8_WAIT_L(0); PG8_BAR; PG8_MMA(1, 0, At, B0); PG8_MMA(1, 1, At, B1); PG8_BAR; PG8_SCHED;
            PG8_LDB(B0, 1, 0); PG8_LDB(B1, 1, 1); PG8_SCHED; PG8_LDA(At, 1, 0); PG8_STAGE(PG8_SA(0, 1), a2 + hstep, voffA);
            PG8_WAIT_V(8); PG8_WAIT_L(0); PG8_BAR; PG8_MMA(0, 0, At, B0); PG8_MMA(0, 1, At, B1); PG8_BAR; PG8_SCHED;
            PG8_LDA(At, 1, 1); PG8_STAGE(PG8_SB(1, 0), b3, voffB); PG8_STAGE(PG8_SB(1, 1), b3 + hstep, voffB); PG8_STAGE(PG8_SA(1, 0), a3, voffA);
            PG8_WAIT_V(8); PG8_WAIT_L(0); PG8_BAR; PG8_MMA(1, 0, At, B0); PG8_MMA(1, 1, At, B1); PG8_BAR; PG8_SCHED;
            } else {
            PG8_LDB(B0, 0, 0); PG8_SCHED; PG8_LDA(At, 0, 0); PG8_STAGE(PG8_SA(1, 1), a1 + hstep, voffA);
            PG8_WAIT_L(8); PG8_BAR; PG8_WAIT_L(0); PG8_MMA(0, 0, At, B0); PG8_BAR; PG8_SCHED;
            PG8_LDB(B1, 0, 1); PG8_STAGE(PG8_SB(0, 0), b2, voffB);
            PG8_BAR; PG8_WAIT_L(0); PG8_MMA(0, 1, At, B1); PG8_BAR;
            PG8_LDA(At, 0, 1); PG8_STAGE(PG8_SA(0, 0), a2, voffA);
            PG8_BAR; PG8_WAIT_L(0); PG8_MMA(1, 0, At, B0); PG8_BAR; PG8_SCHED;
            PG8_STAGE(PG8_SB(0, 1), b2 + hstep, voffB);
            PG8_WAIT_V(6); PG8_BAR; PG8_MMA(1, 1, At, B1); PG8_BAR;
            PG8_LDB(B0, 1, 0); PG8_SCHED; PG8_LDA(At, 1, 0); PG8_STAGE(PG8_SA(0, 1), a2 + hstep, voffA);
            PG8_WAIT_L(8); PG8_BAR; PG8_WAIT_L(0); PG8_MMA(0, 0, At, B0); PG8_BAR; PG8_SCHED;
            PG8_LDB(B1, 1, 1); PG8_STAGE(PG8_SB(1, 0), b3, voffB);
            PG8_BAR; PG8_WAIT_L(0); PG8_MMA(0, 1, At, B1); PG8_BAR;
            PG8_LDA(At, 1, 1); PG8_STAGE(PG8_SA(1, 0), a3, voffA);
            PG8_BAR; PG8_WAIT_L(0); PG8_MMA(1, 0, At, B0); PG8_BAR; PG8_SCHED;
            PG8_STAGE(PG8_SB(1, 1), b3 + hstep, voffB);
            PG8_WAIT_V(6); PG8_BAR; PG8_MMA(1, 1, At, B1); PG8_BAR;
            }
        }
        if constexpr (ALIGN_EPI) { if (wr == 0) PG8_BAR; }
        if constexpr (F8) asm volatile("s_nop 15\n\ts_nop 15" ::: "memory");
        if constexpr (!Epi::AFTER_DRAIN) { if constexpr (Epi::HAS_PREP) { if (has_next && !pre_all) E.prep(rtab + ((ui + 1) & 1) * 256, nxt, wid * 64 + pg8_lane_volatile()); }
            const int l2_ = pg8_lane_volatile(); E(acc, cur, wr, wc, l2_ & 15, l2_ >> 4, rtab + (pre_all ? ui : (ui & 1)) * 256); S.done(cur); }
        if (!has_next) break;
        zz2 = (f32x2z){0.f, 0.f}; asm volatile("" : "+v"(zz2));
#pragma unroll
        for (int a = 0; a < 2; ++a)
#pragma unroll
            for (int b = 0; b < 2; ++b)
#pragma unroll
                for (int m = 0; m < 4; ++m)
#pragma unroll
                    for (int n = 0; n < 2; ++n) { if constexpr (MK_PKZERO) acc[a][b][m][n] = __builtin_shufflevector(zz2, zz2, 0, 1, 0, 1);
                    else { float z_ = 0.f; if constexpr (F8) asm volatile("" : "+v"(z_)); acc[a][b][m][n] = (f32x4){z_, z_, z_, z_}; } }
        epi_stores = E.nst_ok(cur); cur = nxt; cA = nA; cB = nB; ++ui;
        if constexpr (ALIGN_EPI) { if (wr == 1) PG8_BAR; }
    }
    PG8_WAIT_V(0);
    if constexpr (!ALIGN_EPI) { if (wr == 0) PG8_BAR; }
    PG8_BAR;
    if constexpr (Epi::AFTER_DRAIN) { E.fused(acc, cur, wr, wc, fr, fq, lds, wid, lane); S.done(cur); }
#undef PG8_SA
#undef PG8_SB
#undef PG8_STAGE
#undef PG8_LDA
#undef PG8_LDB
#undef PG8_MMA
#undef PG8_CAT8
#undef PG8_WAIT_V
#undef PG8_WAIT_L
#undef PG8_WAIT_VN
#undef PG8_BAR
#undef PG8_SCHED
}
}
namespace pg8 {
constexpr float RMS_EPS = 1e-6f;
typedef unsigned u32x2 __attribute__((ext_vector_type(2)));
constexpr int SSQ_M = 16384;
__device__ __forceinline__ float sigm_f(float g) { return __builtin_amdgcn_rcpf(1.f + __builtin_amdgcn_exp2f(-1.4426950408889634f * g)); }
__device__ __forceinline__ float silu_f(float g) { return g * sigm_f(g); }
__device__ __forceinline__ f32x4 swiglu4(const f32x4 ag, const f32x4 au, const float k1, const float k2) {
    const f32x4 t = ag * k1; f32x4 ex;
    ex[0] = __builtin_amdgcn_exp2f(t[0]); ex[1] = __builtin_amdgcn_exp2f(t[1]); ex[2] = __builtin_amdgcn_exp2f(t[2]); ex[3] = __builtin_amdgcn_exp2f(t[3]);
    const f32x4 d = ex + 1.0f; f32x4 r;
    r[0] = __builtin_amdgcn_rcpf(d[0]); r[1] = __builtin_amdgcn_rcpf(d[1]); r[2] = __builtin_amdgcn_rcpf(d[2]); r[3] = __builtin_amdgcn_rcpf(d[3]);
    return ((ag * au) * k2) * r;
}
__device__ __forceinline__ float bf2f(unsigned short h) { return __uint_as_float((unsigned)h << 16); }
__device__ __forceinline__ f32x4 bf4x(u32x2 w) { f32x4 r; r[0] = __uint_as_float(w.x << 16); r[1] = __uint_as_float(w.x & 0xffff0000u); r[2] = __uint_as_float(w.y << 16); r[3] = __uint_as_float(w.y & 0xffff0000u); return r; }

__device__ __forceinline__ float add_xor1(float v) { return v + __builtin_bit_cast(float, __builtin_amdgcn_update_dpp(0, __builtin_bit_cast(int, v), 0xB1, 0xf, 0xf, true)); }
__device__ __forceinline__ float add_xor2(float v) { return v + __builtin_bit_cast(float, __builtin_amdgcn_update_dpp(0, __builtin_bit_cast(int, v), 0x4E, 0xf, 0xf, true)); }
__device__ __forceinline__ float add_xor4(float v) { return v + __builtin_bit_cast(float, __builtin_amdgcn_ds_swizzle(__builtin_bit_cast(int, v), 0x101F)); }
__device__ __forceinline__ float add_xor16(float v) { return v + __builtin_bit_cast(float, __builtin_amdgcn_ds_swizzle(__builtin_bit_cast(int, v), 0x401F)); }
__device__ __forceinline__ float add_xor32(float v) { const auto r = __builtin_amdgcn_permlane32_swap(__float_as_uint(v), __float_as_uint(v), false, false); return __uint_as_float(r[0]) + __uint_as_float(r[1]); }
__device__ __forceinline__ void prep_rstd(PG8_LAS float* tab, const float* ssq, int pm, int tid) {
    const int r = tid >> 1, hf = tid & 1; const float* p = ssq + (size_t)(hf * 8) * SSQ_M + pm * BM + r; float a[8];
#pragma unroll
    for (int i = 0; i < 8; ++i) a[i] = p[(size_t)i * SSQ_M];
    float s = ((a[0] + a[1]) + (a[2] + a[3])) + ((a[4] + a[5]) + (a[6] + a[7])); s = add_xor1(s);
    if (hf == 0) tab[r] = rsqrtf(s * (1.0f / 1024.0f) + RMS_EPS);
}
template <int SCALE_LOG2 = 0> struct EpiInT {
    static constexpr bool TOUCH = false, PERM = true, AFTER_DRAIN = false, HAS_PREP = true;
    static constexpr int NST = 16;
    __device__ __forceinline__ bool nst_ok(const Unit& u) const { return u.pn != 14; }
    __device__ __forceinline__ void prep(PG8_LAS float* tab, const Unit& u, int tid) const { prep_rstd(tab, ssq, u.pm, tid); }
    bf16_t* zb; size_t arr_stride; float* fg; const float* ssq; float qscale;
    __device__ __forceinline__ void operator()(const f32x4 (&acc)[2][2][4][2], const Unit& u, int wr, int wc, int fr, int fq, const PG8_LAS float* rtab) const {
        const int row0 = u.pm * BM + wr * 64 + fr;
#pragma unroll
        for (int ai = 0; ai < 2; ++ai)
#pragma unroll
            for (int m = 0; m < 4; ++m) {
                const int row = row0 + ai * HALF + m * 16; const float rs = SCALE_LOG2 == 0 ? rtab[ai * HALF + wr * 64 + m * 16 + fr] : rtab[ai * HALF + wr * 64 + m * 16 + fr] * (1.0f / (float)(1 << (SCALE_LOG2 < 0 ? -SCALE_LOG2 : 0)));
                if (u.pn == 14) {
                    if (wc == 0 && fq == 0) { *(f32x4*)(fg + (size_t)row * 8) = acc[ai][0][m][0] * rs; *(f32x4*)(fg + (size_t)row * 8 + 4) = acc[ai][0][m][1] * rs; }
                } else {
                    const float sc = (u.pn < 2) ? rs * qscale : rs;
                    bf16_t* rowp = zb + (size_t)(u.pn >> 1) * arr_stride + (size_t)row * 512 + (u.pn & 1) * 256 + wc * 32 + 8 * fq;
#pragma unroll
                    for (int bj = 0; bj < 2; ++bj) { const f32x4 v0 = acc[ai][bj][m][0] * sc, v1 = acc[ai][bj][m][1] * sc;
                        u32x4 w; w.x = cvt_pk_bf16(v0[0], v0[1]); w.y = cvt_pk_bf16(v0[2], v0[3]); w.z = cvt_pk_bf16(v1[0], v1[1]); w.w = cvt_pk_bf16(v1[2], v1[3]);
                        *(u32x4*)(rowp + bj * HALF) = w; }
                }
            }
    }
};
typedef EpiInT<0> EpiIn;
struct EpiNull {
    static constexpr bool TOUCH = false, PERM = true, AFTER_DRAIN = false, HAS_PREP = false;
    static constexpr int NST = 0;
    __device__ __forceinline__ bool nst_ok(const Unit& u) const { return true; }
    float* sink; int never;
    __device__ __forceinline__ void operator()(const f32x4 (&acc)[2][2][4][2], const Unit& u, int wr, int wc, int fr, int fq, const PG8_LAS float* rtab) const {
        if (never) { f32x4 s = {0.f, 0.f, 0.f, 0.f};
#pragma unroll
            for (int a = 0; a < 2; ++a)
#pragma unroll
                for (int b = 0; b < 2; ++b)
#pragma unroll
                    for (int m = 0; m < 4; ++m) { s += acc[a][b][m][0]; s += acc[a][b][m][1]; }
            *(f32x4*)(sink + (size_t)(wr * 4 + wc) * 256 + (fq * 16 + fr) * 4) = s; }
    }
};
struct EpiPlain {
    static constexpr bool TOUCH = false, PERM = true, AFTER_DRAIN = false, HAS_PREP = false;
    static constexpr int NST = 16;
    __device__ __forceinline__ bool nst_ok(const Unit& u) const { return true; }
    bf16_t* O; int ldc; float scale;
    __device__ __forceinline__ void operator()(const f32x4 (&acc)[2][2][4][2], const Unit& u, int wr, int wc, int fr, int fq, const PG8_LAS float* rtab) const {
        const int row0 = u.pm * BM + wr * 64 + fr, col0 = u.pn * BM + wc * 32 + 8 * fq;
#pragma unroll
        for (int ai = 0; ai < 2; ++ai)
#pragma unroll
            for (int m = 0; m < 4; ++m) { bf16_t* rowp = O + (size_t)(row0 + ai * HALF + m * 16) * ldc + col0;
#pragma unroll
                for (int bj = 0; bj < 2; ++bj) { const f32x4 v0 = acc[ai][bj][m][0] * scale, v1 = acc[ai][bj][m][1] * scale;
                    u32x4 w; w.x = cvt_pk_bf16(v0[0], v0[1]); w.y = cvt_pk_bf16(v0[2], v0[3]); w.z = cvt_pk_bf16(v1[0], v1[1]); w.w = cvt_pk_bf16(v1[2], v1[3]);
                    *(u32x4*)(rowp + bj * HALF) = w; } }
    }
};
template <bool NORM> struct EpiSwi {
    static constexpr bool TOUCH = false, PERM = true, AFTER_DRAIN = false, HAS_PREP = NORM;
    static constexpr int NST = 8;
    __device__ __forceinline__ bool nst_ok(const Unit& u) const { return true; }
    bf16_t* O; int ldc; const float* ssq;
    __device__ __forceinline__ void prep(PG8_LAS float* tab, const Unit& u, int tid) const { prep_rstd(tab, ssq, u.pm, tid); }
    __device__ __forceinline__ void operator()(const f32x4 (&acc)[2][2][4][2], const Unit& u, int wr, int wc, int fr, int fq, const PG8_LAS float* rtab) const {
        const int row0 = u.pm * BM + wr * 64 + fr, col0 = u.pn * HALF + wc * 32 + 8 * fq;
#pragma unroll
        for (int ai = 0; ai < 2; ++ai)
#pragma unroll
            for (int m = 0; m < 4; ++m) { const int row = row0 + ai * HALF + m * 16; const float rs = NORM ? rtab[ai * HALF + wr * 64 + m * 16 + fr] : 1.0f;
                const float k1 = -1.4426950408889634f * rs, k2 = rs * rs;
                const f32x4 o0 = swiglu4(acc[ai][0][m][0], acc[ai][1][m][0], k1, k2), o1 = swiglu4(acc[ai][0][m][1], acc[ai][1][m][1], k1, k2);
                u32x4 w; w.x = cvt_pk_bf16(o0[0], o0[1]); w.y = cvt_pk_bf16(o0[2], o0[3]); w.z = cvt_pk_bf16(o1[0], o1[1]); w.w = cvt_pk_bf16(o1[2], o1[3]);
                *(u32x4*)(O + (size_t)row * ldc + col0) = w; }
    }
};
__device__ __forceinline__ float clamp448(float v) { return __builtin_fminf(__builtin_fmaxf(v, -448.f), 448.f); }
__device__ __forceinline__ unsigned pack4_fp8(float a, float b, float c, float d) {
    int w = __builtin_amdgcn_cvt_pk_fp8_f32(clamp448(a), clamp448(b), 0, false); w = __builtin_amdgcn_cvt_pk_fp8_f32(clamp448(c), clamp448(d), w, true); return (unsigned)w; }
template <bool NORM> struct EpiSwi8 {
    static constexpr bool TOUCH = false, PERM = true, AFTER_DRAIN = false, HAS_PREP = NORM;
    static constexpr int NST = 8;
    __device__ __forceinline__ bool nst_ok(const Unit& u) const { return true; }
    unsigned char* O; int ldc; float inv_in, out_scale; const float* ssq;
    __device__ __forceinline__ void prep(PG8_LAS float* tab, const Unit& u, int tid) const { prep_rstd(tab, ssq, u.pm, tid); }
    __device__ __forceinline__ void operator()(const f32x4 (&acc)[2][2][4][2], const Unit& u, int wr, int wc, int fr, int fq, const PG8_LAS float* rtab) const {
        const int row0 = u.pm * BM + wr * 64 + fr, col0 = u.pn * HALF + wc * 32 + 8 * fq;
#pragma unroll
        for (int ai = 0; ai < 2; ++ai)
#pragma unroll
            for (int m = 0; m < 4; ++m) { const int row = row0 + ai * HALF + m * 16; const float sc = NORM ? inv_in * rtab[ai * HALF + wr * 64 + m * 16 + fr] : inv_in;
                const float k1 = -1.4426950408889634f * sc, k2 = sc * sc * out_scale;
                const f32x4 o0 = swiglu4(acc[ai][0][m][0], acc[ai][1][m][0], k1, k2), o1 = swiglu4(acc[ai][0][m][1], acc[ai][1][m][1], k1, k2);
                u32x2 w; w.x = pack4_fp8(o0[0], o0[1], o0[2], o0[3]); w.y = pack4_fp8(o1[0], o1[1], o1[2], o1[3]);
                *(u32x2*)(O + (size_t)row * ldc + col0) = w; }
    }
};
template <int SCALE_LOG2 = 0, long H8_DELTA = 0, int H8_LOG2 = 0> struct EpiRes {
    static constexpr bool TOUCH = true, PERM = true, AFTER_DRAIN = false, HAS_PREP = false;
    static constexpr int NST = 0;
    __device__ __forceinline__ bool nst_ok(const Unit& u) const { return true; }
    bf16_t* hb; float* ssq_out;
    __device__ __forceinline__ void operator()(const f32x4 (&acc)[2][2][4][2], const Unit& u, int wr, int wc, int fr, int fq, const PG8_LAS float* rtab) const {
        const int row0 = u.pm * BM + wr * 64 + fr, col0 = u.pn * BM + wc * 32 + 8 * fq;
        constexpr float scale = SCALE_LOG2 >= 0 ? (float)(1 << (SCALE_LOG2 >= 0 ? SCALE_LOG2 : 0)) : 1.0f / (float)(1 << (SCALE_LOG2 < 0 ? -SCALE_LOG2 : 0));
#pragma unroll
        for (int ai = 0; ai < 2; ++ai) {
            u32x4 hv[4][2];
#pragma unroll
            for (int m = 0; m < 4; ++m)
#pragma unroll
                for (int bj = 0; bj < 2; ++bj) hv[m][bj] = *(const u32x4*)(hb + (size_t)(row0 + ai * HALF + m * 16) * 1024 + col0 + bj * HALF);
#pragma unroll
            for (int m = 0; m < 4; ++m) { const int row = row0 + ai * HALF + m * 16; const size_t off = (size_t)row * 1024 + col0; f32x4 s4 = {0.f, 0.f, 0.f, 0.f};
#pragma unroll
                for (int bj = 0; bj < 2; ++bj) { const size_t o2 = off + bj * HALF; u32x2 lo, hi; lo.x = hv[m][bj].x; lo.y = hv[m][bj].y; hi.x = hv[m][bj].z; hi.y = hv[m][bj].w;
                    const f32x4 o0 = SCALE_LOG2 == 0 ? bf4x(lo) + acc[ai][bj][m][0] : bf4x(lo) + acc[ai][bj][m][0] * scale, o1 = SCALE_LOG2 == 0 ? bf4x(hi) + acc[ai][bj][m][1] : bf4x(hi) + acc[ai][bj][m][1] * scale;
                    s4 += o0 * o0; s4 += o1 * o1;
                    u32x4 w; w.x = cvt_pk_bf16(o0[0], o0[1]); w.y = cvt_pk_bf16(o0[2], o0[3]); w.z = cvt_pk_bf16(o1[0], o1[1]); w.w = cvt_pk_bf16(o1[2], o1[3]); *(u32x4*)(hb + o2) = w;
                    if constexpr (H8_DELTA != 0) { constexpr float h8s = (float)(1 << H8_LOG2); u32x2 q; q.x = pack4_fp8(o0[0] * h8s, o0[1] * h8s, o0[2] * h8s, o0[3] * h8s); q.y = pack4_fp8(o1[0] * h8s, o1[1] * h8s, o1[2] * h8s, o1[3] * h8s);
                        *(u32x2*)((unsigned char*)hb + H8_DELTA + o2) = q; } }
                float s = (s4[0] + s4[1]) + (s4[2] + s4[3]); s = add_xor16(s); s = add_xor32(s);
                if (fq == 0) ssq_out[(size_t)(u.pn * 4 + wc) * SSQ_M + row] = s; }
            asm volatile("" ::: "memory"); }
    }
};
struct EpiP2 {
    static constexpr bool TOUCH = false, PERM = true, AFTER_DRAIN = false, HAS_PREP = false;
    static constexpr int NST = 0;
    __device__ __forceinline__ bool nst_ok(const Unit& u) const { return true; }
    bf16_t* P2;
    __device__ __forceinline__ void operator()(const f32x4 (&acc)[2][2][4][2], const Unit& u, int wr, int wc, int fr, int fq, const PG8_LAS float* rtab) const {
        const int row0 = u.pm * BM + wr * 64 + fr, col0 = u.pn * BM + wc * 32 + 8 * fq;
#pragma unroll
        for (int ai = 0; ai < 2; ++ai)
#pragma unroll
            for (int m = 0; m < 4; ++m) { const size_t off = (size_t)(row0 + ai * HALF + m * 16) * 1024 + col0;
#pragma unroll
                for (int bj = 0; bj < 2; ++bj) { const f32x4 o0 = acc[ai][bj][m][0], o1 = acc[ai][bj][m][1];
                    u32x4 w; w.x = cvt_pk_bf16(o0[0], o0[1]); w.y = cvt_pk_bf16(o0[2], o0[3]); w.z = cvt_pk_bf16(o1[0], o1[1]); w.w = cvt_pk_bf16(o1[2], o1[3]); *(u32x4*)(P2 + off + bj * HALF) = w; } }
    }
};
template <long H8_DELTA = 0, int H8_LOG2 = 0> struct EpiPleT {
    static constexpr bool TOUCH = true, PERM = true, AFTER_DRAIN = false, HAS_PREP = true;
    static constexpr int NST = 0;
    __device__ __forceinline__ bool nst_ok(const Unit& u) const { return true; }
    __device__ __forceinline__ void prep(PG8_LAS float* tab, const Unit& u, int tid) const { prep_rstd(tab, ssq_in, u.pm, tid); }
    const bf16_t* P2; bf16_t* hb; const float* ssq_in; float* ssq_out;
    __device__ __forceinline__ void operator()(const f32x4 (&acc)[2][2][4][2], const Unit& u, int wr, int wc, int fr, int fq, const PG8_LAS float* rtab) const {
        const int row0 = u.pm * BM + wr * 64 + fr, col0 = u.pn * BM + wc * 32 + 8 * fq;
#pragma unroll
        for (int ai = 0; ai < 2; ++ai) {
            u32x4 hv[4][2], pv[4][2];
#pragma unroll
            for (int m = 0; m < 4; ++m)
#pragma unroll
                for (int bj = 0; bj < 2; ++bj) { const size_t o2 = (size_t)(row0 + ai * HALF + m * 16) * 1024 + col0 + bj * HALF; hv[m][bj] = *(const u32x4*)(hb + o2); pv[m][bj] = *(const u32x4*)(P2 + o2); }
#pragma unroll
            for (int m = 0; m < 4; ++m) { const int row = row0 + ai * HALF + m * 16; const size_t off = (size_t)row * 1024 + col0; const float k1 = -1.4426950408889634f * rtab[ai * HALF + wr * 64 + m * 16 + fr]; f32x4 s4 = {0.f, 0.f, 0.f, 0.f};
#pragma unroll
                for (int bj = 0; bj < 2; ++bj) { const size_t o2 = off + bj * HALF; u32x4 w; unsigned q8[2] = {0u, 0u};
#pragma unroll
                    for (int n = 0; n < 2; ++n) { u32x2 hh, pp; hh.x = n ? hv[m][bj].z : hv[m][bj].x; hh.y = n ? hv[m][bj].w : hv[m][bj].y; pp.x = n ? pv[m][bj].z : pv[m][bj].x; pp.y = n ? pv[m][bj].w : pv[m][bj].y;
                        const f32x4 t = acc[ai][bj][m][n] * k1; f32x4 ex, r;
                        ex[0] = __builtin_amdgcn_exp2f(t[0]); ex[1] = __builtin_amdgcn_exp2f(t[1]); ex[2] = __builtin_amdgcn_exp2f(t[2]); ex[3] = __builtin_amdgcn_exp2f(t[3]);
                        const f32x4 d = ex + 1.0f;
                        r[0] = __builtin_amdgcn_rcpf(d[0]); r[1] = __builtin_amdgcn_rcpf(d[1]); r[2] = __builtin_amdgcn_rcpf(d[2]); r[3] = __builtin_amdgcn_rcpf(d[3]);
                        const f32x4 o = bf4x(hh) + bf4x(pp) * r;
                        s4 += o * o;
                        const unsigned c0 = cvt_pk_bf16(o[0], o[1]), c1 = cvt_pk_bf16(o[2], o[3]); if (n) { w.z = c0; w.w = c1; } else { w.x = c0; w.y = c1; }
                        if constexpr (H8_DELTA != 0) { const f32x4 o8 = o * (float)(1 << H8_LOG2); q8[n] = pack4_fp8(o8[0], o8[1], o8[2], o8[3]); } }
                    *(u32x4*)(hb + o2) = w;
                    if constexpr (H8_DELTA != 0) { u32x2 q; q.x = q8[0]; q.y = q8[1]; *(u32x2*)((unsigned char*)hb + H8_DELTA + o2) = q; } }
                float s = (s4[0] + s4[1]) + (s4[2] + s4[3]); s = add_xor16(s); s = add_xor32(s);
                if (fq == 0) ssq_out[(size_t)(u.pn * 4 + wc) * SSQ_M + row] = s; }
            asm volatile("" ::: "memory"); }
    }
};
typedef EpiPleT<0, 0> EpiPle;
struct MoeOrder {
    int nM, nN, nwg, G, c, nlim; int tpre[9]; int emask = 7;
    __device__ __forceinline__ void map(int L, Unit& u) const {
        int wgid = L; { const int q = nwg / NXCD, r = nwg % NXCD, xcd = wgid % NXCD, off = wgid / NXCD; wgid = (xcd < r ? xcd * (q + 1) : r * (q + 1) + (xcd - r) * q) + off; }
        const int nig = MK_MOE_WGM * nN, gid = wgid / nig, fm = gid * MK_MOE_WGM, gsz = (nM - fm) < MK_MOE_WGM ? (nM - fm) : MK_MOE_WGM;
        u.pm = fm + ((wgid % nig) % gsz); u.pn = (wgid % nig) / gsz;
        int e = 0;
#pragma unroll
        for (int k = 1; k < 8; ++k) e += (u.pm >= tpre[k]) ? 1 : 0;
        u.pb = (MK_PROBE == 21 ? (e & emask) : e) * nN + u.pn; u.koff = 0; u.tag = 0;
    }
    __device__ __forceinline__ bool next(int i, Unit& u) const { const long L = (long)i * G + c; if (L >= nlim) return false; map((int)L, u); return true; }
    __device__ __forceinline__ void a_ready(const Unit&) const {}
    __device__ __forceinline__ void done(const Unit&) const {}
};
struct LeftOrder {
    MoeOrder base; int L0, nleft, c, kq_len, split;
    __device__ __forceinline__ bool next(int i, Unit& u) const { if (i > 0 || c >= split * nleft) return false; const int j = c / split, kq = c - j * split; base.map(L0 + j, u); u.koff = kq * kq_len; u.tag = j * 8 + kq; return true; }
    __device__ __forceinline__ void a_ready(const Unit&) const {}
    __device__ __forceinline__ void done(const Unit&) const {}
};
__device__ __forceinline__ void moe_split_plan(int nwg, int G, int& L0, int& nleft) { L0 = (nwg / G) * G; nleft = nwg - L0; if (nleft * 4 > G || G != 256) { L0 = nwg; nleft = 0; } }
struct EpiPlainSplit {
    static constexpr bool TOUCH = false, PERM = true, AFTER_DRAIN = false, HAS_PREP = false;
    static constexpr int NST = 0;
    __device__ __forceinline__ bool nst_ok(const Unit& u) const { return true; }
    bf16_t* Y; bf16_t* YP; float scale; int np;
    __device__ __forceinline__ void operator()(const f32x4 (&acc)[2][2][4][2], const Unit& u, int wr, int wc, int fr, int fq, const PG8_LAS float* rtab) const {
        const int kq = u.tag & 7, j = u.tag >> 3; const int ldc = kq ? 256 : 1024;
        bf16_t* base = kq ? YP + (size_t)(j * np + kq - 1) * 65536 : Y + (size_t)u.pm * BM * 1024 + u.pn * BM;
        const int row0 = wr * 64 + fr, col0 = wc * 32 + 8 * fq;
#pragma unroll
        for (int ai = 0; ai < 2; ++ai)
#pragma unroll
            for (int m = 0; m < 4; ++m) { bf16_t* rowp = base + (size_t)(row0 + ai * HALF + m * 16) * ldc + col0;
#pragma unroll
                for (int bj = 0; bj < 2; ++bj) { const f32x4 v0 = acc[ai][bj][m][0] * scale, v1 = acc[ai][bj][m][1] * scale;
                    u32x4 w; w.x = cvt_pk_bf16(v0[0], v0[1]); w.y = cvt_pk_bf16(v0[2], v0[3]); w.z = cvt_pk_bf16(v1[0], v1[1]); w.w = cvt_pk_bf16(v1[2], v1[3]);
                    *(u32x4*)(rowp + bj * HALF) = w; } }
    }
};
}
#include <hip/hip_bf16.h>
#include <cmath>
namespace attn_body {
using bf16=__hip_bfloat16;
using bf16x8=__attribute__((ext_vector_type(8)))short;
using s16x4=__attribute__((ext_vector_type(4)))short;
using f32x16=__attribute__((ext_vector_type(16)))float;
using u32x4=__attribute__((ext_vector_type(4)))unsigned;
constexpr int BATCH=8,NHEAD=8,SEQ=2048,D=64,DM=512,MIXP=1024;
constexpr int NW=8,QBLK=32,QB=QBLK*NW,KVBLK=64,NQB=SEQ/QB;
constexpr int ATTN_PITCH=DM, ATTN_UNIT_ROWS=QB;
__device__ __forceinline__ int crow(int r,int hi){return (r&3)+8*(r>>2)+4*hi;}
#define SBAR() __builtin_amdgcn_sched_barrier(0)
__device__ __forceinline__ void cmask(f32x16&p0,f32x16&p1,int jb,int qrel,int hi){
  const float NEG=-INFINITY; int kb=64*jb+4*hi;
  #pragma unroll
  for(int r=0;r<16;++r){int kv=kb+(r&3)+8*(r>>2); if(kv>qrel)p0[r]=NEG; if(kv+32>qrel)p1[r]=NEG;}
}

constexpr int NSLOT=3, SLOTB=8192;
constexpr int LDS_K=0, LDS_V=NSLOT*SLOTB, LDS_WS=2*NSLOT*SLOTB, LDS_OST=LDS_WS+NW*64*4, LDS_BIAS=LDS_OST+NW*4096, LDS_BYTES=LDS_BIAS+SEQ*4;
constexpr float C2=0.125f*1.4426950408889634f;
__device__ __forceinline__ void glds16(const void*gsrc,unsigned lds_dst){unsigned keep;
  asm volatile("s_mov_b32 %0, m0\n\ts_mov_b32 m0, %2\n\ts_nop 0\n\tglobal_load_lds_dwordx4 %1, off\n\ts_mov_b32 m0, %0":"=&s"(keep):"v"(gsrc),"s"(lds_dst):"memory");}
__device__ __forceinline__ float max3f(float a,float b,float c){float r;asm("v_max3_f32 %0, %1, %2, %3":"=v"(r):"v"(a),"v"(b),"v"(c));return r;}
__device__ __forceinline__ float max2f(float a,float b){float r;asm("v_max_f32_e32 %0, %1, %2":"=v"(r):"v"(a),"v"(b));return r;}
__device__ __forceinline__ float fadd_s(float a,float b){float r;asm("v_add_f32_e32 %0, %1, %2":"=v"(r):"v"(a),"v"(b));return r;}
__device__ __forceinline__ float fsub_s(float a,float b){float r;asm("v_sub_f32_e32 %0, %1, %2":"=v"(r):"v"(a),"v"(b));return r;}
typedef float f32x2_t __attribute__((ext_vector_type(2))); typedef __bf16 bf16x2_t __attribute__((ext_vector_type(2)));
__device__ __forceinline__ unsigned cvtpk_s(float lo,float hi){f32x2_t v={lo,hi};bf16x2_t b=__builtin_convertvector(v,bf16x2_t);return __builtin_bit_cast(unsigned,b);}
#define WAIT_BAR(N) asm volatile("s_waitcnt vmcnt(" #N ") lgkmcnt(0)\n\ts_barrier":::"memory")

__device__ __forceinline__ void qkt(f32x16&p0,f32x16&p1,const char*Kslot,const bf16x8*qr,int r32,int hi){
  const char*kb=Kslot+hi*1024+r32*16;
  #pragma unroll
  for(int d0=0;d0<4;++d0){
    const bf16x8 b0=*reinterpret_cast<const bf16x8*>(kb+d0*2048);
    const bf16x8 b1=*reinterpret_cast<const bf16x8*>(kb+d0*2048+512);
    if(d0==0){p0=__builtin_amdgcn_mfma_f32_32x32x16_bf16(b0,qr[0],f32x16{},0,0,0);p1=__builtin_amdgcn_mfma_f32_32x32x16_bf16(b1,qr[0],f32x16{},0,0,0);}
    else{p0=__builtin_amdgcn_mfma_f32_32x32x16_bf16(b0,qr[d0],p0,0,0,0);p1=__builtin_amdgcn_mfma_f32_32x32x16_bf16(b1,qr[d0],p1,0,0,0);}}
}
typedef __attribute__((address_space(3))) const char* lds_cptr;
typedef short v4i16_t __attribute__((ext_vector_type(4)));
__device__ __forceinline__ void kload8(bf16x8*kf,lds_cptr kp){
  kf[0]=*(const __attribute__((address_space(3))) bf16x8*)(kp);      kf[1]=*(const __attribute__((address_space(3))) bf16x8*)(kp+512);
  kf[2]=*(const __attribute__((address_space(3))) bf16x8*)(kp+2048); kf[3]=*(const __attribute__((address_space(3))) bf16x8*)(kp+2560);
  kf[4]=*(const __attribute__((address_space(3))) bf16x8*)(kp+4096); kf[5]=*(const __attribute__((address_space(3))) bf16x8*)(kp+4608);
  kf[6]=*(const __attribute__((address_space(3))) bf16x8*)(kp+6144); kf[7]=*(const __attribute__((address_space(3))) bf16x8*)(kp+6656);
}
__device__ __forceinline__ void kload2(bf16x8*kf,lds_cptr kp,int j){ kf[2*j]=*(const __attribute__((address_space(3))) bf16x8*)(kp+j*2048); kf[2*j+1]=*(const __attribute__((address_space(3))) bf16x8*)(kp+j*2048+512); }
__device__ __forceinline__ s16x4 vtr(lds_cptr p){ return __builtin_bit_cast(s16x4,__builtin_amdgcn_ds_read_tr16_b64_v4i16((__attribute__((address_space(3))) v4i16_t*)p)); }
__device__ __forceinline__ float rowmax(const f32x16&p0,const f32x16&p1){
  float a=max3f(p0[0],p0[1],p1[0]),b=max3f(p0[2],p0[3],p1[1]);a=max3f(a,p1[2],p1[3]);
  #pragma unroll
  for(int r=4;r<16;r+=4){a=max3f(a,p0[r],p0[r+1]);b=max3f(b,p0[r+2],p0[r+3]);a=max3f(a,p1[r],p1[r+1]);b=max3f(b,p1[r+2],p1[r+3]);}
  const float m=max2f(a,b);
  auto rr=__builtin_amdgcn_permlane32_swap(__float_as_uint(m),__float_as_uint(m),false,false);
  return max2f(__uint_as_float(rr[0]),__uint_as_float(rr[1]));
}
__device__ __forceinline__ void pv(f32x16*o,int vb,bf16x8 pa0,bf16x8 pa1,bf16x8 pa2,bf16x8 pa3){
  #pragma unroll
  for(int d0=0;d0<2;++d0){s16x4 lo[4],hi[4];
    #pragma unroll
    for(int ks=0;ks<4;++ks){
      asm volatile("ds_read_b64_tr_b16 %0,%1 offset:%c2":"=&v"(lo[ks]):"v"(vb),"i"(d0*4096+ks*1024):"memory");
      asm volatile("ds_read_b64_tr_b16 %0,%1 offset:%c2":"=&v"(hi[ks]):"v"(vb),"i"(d0*4096+ks*1024+512):"memory");}
    asm volatile("s_waitcnt lgkmcnt(0)":::"memory");SBAR();
    #define PK(k) (bf16x8){lo[k][0],lo[k][1],lo[k][2],lo[k][3],hi[k][0],hi[k][1],hi[k][2],hi[k][3]}
    o[d0]=__builtin_amdgcn_mfma_f32_32x32x16_bf16(pa0,PK(0),o[d0],0,0,0);
    o[d0]=__builtin_amdgcn_mfma_f32_32x32x16_bf16(pa1,PK(1),o[d0],0,0,0);
    o[d0]=__builtin_amdgcn_mfma_f32_32x32x16_bf16(pa2,PK(2),o[d0],0,0,0);
    o[d0]=__builtin_amdgcn_mfma_f32_32x32x16_bf16(pa3,PK(3),o[d0],0,0,0);
    #undef PK
  }
}

#ifndef ATTN_STORE16
#define ATTN_STORE16(p,v) (*(u32x4*)(p)=(v))
#endif
typedef float f32x4_t __attribute__((ext_vector_type(4)));
template<int THRL> __device__ __forceinline__ void attn_unit(int b,int h,int qb,const bf16*Q,const bf16*__restrict__ K,const bf16*__restrict__ V,const float*__restrict__ cb,const float*__restrict__ gain,bf16*MIX,char*shm,int tid_in){
  const int tid=tid_in,lane=tid&63,r32=lane&31,hi=lane>>5; const int wid=__builtin_amdgcn_readfirstlane(tid>>6);
  const long rowbase=(long)b*SEQ; const int q0=qb*QB;
  const int NT_all=(q0+QB)/KVBLK; int t0;
  { const float cref0=cb[q0]; const bool cand=lane<NT_all-4; const float ce=cand?cb[64*lane+63]:cref0;
    const unsigned long long mk=__ballot(cand&&((cref0-ce)*1.4426950408889634f<-64.0f)); t0=__builtin_amdgcn_readfirstlane((int)__builtin_ctzll(~mk)&~1); }
  const bf16*Qw=Q+(rowbase+q0+wid*QBLK)*DM+h*D;
  const bf16*Kh=K+(rowbase+t0*KVBLK)*DM+h*D,*Vh=V+(rowbase+t0*KVBLK)*DM+h*D;
  const unsigned lds0=(unsigned)(uintptr_t)shm;
  float*wsf=(float*)(shm+LDS_WS)+wid*64;
  const bf16*ksrc=Kh+(long)lane*DM+wid*8;
  const bf16*vsrc=Vh+(long)(16*(wid&3)+(lane>>2))*DM+(wid>>2)*32+(lane&3)*8;
  const unsigned kdst=lds0+LDS_K+wid*1024, vdst=lds0+LDS_V+wid*1024;
  #define DMA_K(t,slot) glds16(ksrc+(long)(t)*KVBLK*DM,(unsigned)__builtin_amdgcn_readfirstlane(kdst+(slot)))
  #define DMA_V(t,slot) glds16(vsrc+(long)(t)*KVBLK*DM,(unsigned)__builtin_amdgcn_readfirstlane(vdst+(slot)))
  const int vb0=(int)(lds0+LDS_V)+((lane>>4)&1)*32+(lane&3)*8+(4*hi+((lane&15)>>2))*64;
  const char*Kbase=shm+LDS_K; bf16x8 kf[8];
  const lds_cptr shm3=(lds_cptr)shm; const lds_cptr kp0=shm3+LDS_K+hi*1024+r32*16; const lds_cptr vp0=shm3+LDS_V+((lane>>4)&1)*32+(lane&3)*8+(4*hi+((lane&15)>>2))*64;
  const int NT=NT_all-t0;
  const float cref=cb[q0]; const int bi4=tid*4; f32x4_t bv4=(f32x4_t){0.f,0.f,0.f,0.f}; if(bi4<NT*KVBLK)bv4=*(const f32x4_t*)(cb+t0*KVBLK+bi4);
  const float cqrow=cb[q0+wid*QBLK+r32];
  #define BIAS(P0,P1,t) do{ const __attribute__((address_space(3))) f32x4_t*bp_=(const __attribute__((address_space(3))) f32x4_t*)(shm3+LDS_BIAS)+(t)*16+hi; \
    _Pragma("unroll") for(int j_=0;j_<4;++j_){ const f32x4_t b0_=bp_[2*j_]-mhat,b1_=bp_[2*j_+8]-mhat; \
      P0[4*j_]+=b0_[0];P0[4*j_+1]+=b0_[1];P0[4*j_+2]+=b0_[2];P0[4*j_+3]+=b0_[3];P1[4*j_]+=b1_[0];P1[4*j_+1]+=b1_[1];P1[4*j_+2]+=b1_[2];P1[4*j_+3]+=b1_[3]; } }while(0)
  DMA_K(0,0);DMA_V(0,0);DMA_K(1,SLOTB);
  bf16x8 qr[4];
  #pragma unroll
  for(int d0=0;d0<4;++d0)qr[d0]=*reinterpret_cast<const bf16x8*>(&Qw[(long)r32*DM+d0*16+hi*8]);
  { float*bl=(float*)(shm+LDS_BIAS); if(bi4<NT*KVBLK)*(f32x4_t*)(bl+bi4)=(cref-bv4)*1.4426950408889634f; }
  float mhat=(cref-cqrow)*1.4426950408889634f,l_reg=0.f;f32x16 o[2];{float z0_=0.f;asm volatile("":"+v"(z0_));
    _Pragma("unroll") for(int r=0;r<16;++r){o[0][r]=z0_;o[1][r]=z0_;}}
  const int qrel=wid*QBLK+r32;
  #define CMASK(P0,P1,t) do{int jb_=(t)-(NT-4); if(jb_>=0)cmask(P0,P1,jb_,qrel,hi);}while(0)
  bool resc=false;
  #define START(P0,P1) do{ resc=false; \
    _Pragma("unroll") for(int r=0;r<16;++r)P0[r]=__builtin_amdgcn_exp2f(P0[r]); }while(0)
  #define RESC() do{ if(resc){ asm volatile("s_waitcnt lgkmcnt(0)":::"memory"); \
      _Pragma("unroll") for(int d_=0;d_<2;++d_) _Pragma("unroll") for(int r=0;r<16;++r)o[d_][r]*=wsf[crow(r,hi)]; } }while(0)
  f32x16 pA0,pA1,pB0,pB1;
  int sl_prev=0,sl_cur=0,sl_next=SLOTB;
  #define ROT() do{sl_prev=sl_cur;sl_cur=sl_next;sl_next=(sl_next==(NSLOT-1)*SLOTB)?0:sl_next+SLOTB;}while(0)
  DMA_K(2,2*SLOTB);
  WAIT_BAR(3);
  qkt(pA0,pA1,Kbase,qr,r32,hi);asm volatile("s_nop 15\n\ts_nop 7":"+v"(pA0),"+v"(pA1));BIAS(pA0,pA1,0);CMASK(pA0,pA1,0);
  START(pA0,pA1);
  _Pragma("unroll") for(int r=0;r<16;++r)pA1[r]=__builtin_amdgcn_exp2f(pA1[r]);
  WAIT_BAR(0);
  DMA_K(3,0);DMA_V(1,SLOTB);
  ROT();
  kload8(kf,kp0+sl_cur);
  WAIT_BAR(2);
  s16x4 vlo[8],vhi[8]; u32x4 pw0,pw1,pw2,pw3;
  #define PKW(P,B) cvtpk_s(P[B],P[B+1])
  #define PAF(k) __builtin_bit_cast(bf16x8,pw##k)
  #define VFR(i) (bf16x8){vlo[i][0],vlo[i][1],vlo[i][2],vlo[i][3],vhi[i][0],vhi[i][1],vhi[i][2],vhi[i][3]}
  #define PIN(x) asm volatile("":"+v"(x))
  #define MX3(a,b,c) __builtin_fmaxf(__builtin_fmaxf((a),(b)),(c))
  #define GAPA(MF,A0,A1,A2,A3,W0,W1,PW) do{ MF; sacc+=A0; sacc+=A1; sacc+=A2; sacc+=A3; PIN(sacc); W0; W1; PIN(PW); SBAR(); }while(0)
  #define EX(v) __builtin_amdgcn_exp2f(v)
  #define GAPB(MF,X,B) do{ MF; X[B]=EX(X[B]); X[B+1]=EX(X[B+1]); X[B+2]=EX(X[B+2]); X[B+3]=EX(X[B+3]); PIN(X); SBAR(); }while(0)
  #define VRD(i) do{ vlo[i]=vtr(vp_+(((i)>>2)*4096+((i)&3)*1024)); vhi[i]=vtr(vp_+(((i)>>2)*4096+((i)&3)*1024+512)); }while(0)
  #define KRD(G,j) do{ if(G){ kload2(kf,kp0+sl_next,j); SBAR(); } }while(0)
  #define STEP(C0,C1,P0,P1,t,GK,GV,GL) do{ SBAR(); \
    const lds_cptr vp_=vp0+sl_prev; \
    VRD(0); SBAR(); float sacc=(P0[0]+P0[1]); \
    GAPA(C0=__builtin_amdgcn_mfma_f32_32x32x16_bf16(kf[0],qr[0],f32x16{},0,0,0), P0[2],P0[3],P0[4],P0[5],     pw0[0]=PKW(P0,0), pw0[1]=PKW(P0,2), pw0); \
    VRD(4); SBAR(); GAPA(C1=__builtin_amdgcn_mfma_f32_32x32x16_bf16(kf[1],qr[0],f32x16{},0,0,0), P0[6],P0[7],P0[8],P0[9],     pw0[2]=PKW(P0,4), pw0[3]=PKW(P0,6), pw0); \
    VRD(1); SBAR(); GAPA(C0=__builtin_amdgcn_mfma_f32_32x32x16_bf16(kf[2],qr[1],C0,0,0,0),   P0[10],P0[11],P0[12],P0[13], pw1[0]=PKW(P0,8), pw1[1]=PKW(P0,10), pw1); \
    VRD(5); SBAR(); GAPA(C1=__builtin_amdgcn_mfma_f32_32x32x16_bf16(kf[3],qr[1],C1,0,0,0),   P0[14],P0[15],P1[0],P1[1],   pw1[2]=PKW(P0,12),pw1[3]=PKW(P0,14), pw1); \
    VRD(2); SBAR(); GAPA(C0=__builtin_amdgcn_mfma_f32_32x32x16_bf16(kf[4],qr[2],C0,0,0,0),   P1[2],P1[3],P1[4],P1[5],     pw2[0]=PKW(P1,0), pw2[1]=PKW(P1,2), pw2); \
    VRD(6); SBAR(); GAPA(C1=__builtin_amdgcn_mfma_f32_32x32x16_bf16(kf[5],qr[2],C1,0,0,0),   P1[6],P1[7],P1[8],P1[9],     pw2[2]=PKW(P1,4), pw2[3]=PKW(P1,6), pw2); \
    VRD(3); SBAR(); GAPA(C0=__builtin_amdgcn_mfma_f32_32x32x16_bf16(kf[6],qr[3],C0,0,0,0),   P1[10],P1[11],P1[12],P1[13], pw3[0]=PKW(P1,8), pw3[1]=PKW(P1,10), pw3); \
    VRD(7); SBAR(); GAPA(C1=__builtin_amdgcn_mfma_f32_32x32x16_bf16(kf[7],qr[3],C1,0,0,0),   P1[14],P1[15],0.f,0.f,       pw3[2]=PKW(P1,12),pw3[3]=PKW(P1,14), pw3); \
    l_reg+=sacc; \
    if(GK){DMA_K((t)+3,sl_cur);} if(GV){DMA_V((t)+1,sl_next);} \
    BIAS(C0,C1,t); CMASK(C0,C1,t); \
    { float a=MX3(C0[0],C0[1],C1[0]),b=MX3(C0[2],C0[3],C1[1]); a=MX3(a,C1[2],C1[3]); \
      _Pragma("unroll") for(int r=4;r<16;r+=4){a=MX3(a,C0[r],C0[r+1]);b=MX3(b,C0[r+2],C0[r+3]);a=MX3(a,C1[r],C1[r+1]);b=MX3(b,C1[r+2],C1[r+3]);} \
      float rm=__builtin_fmaxf(a,b); { auto rr=__builtin_amdgcn_permlane32_swap(__float_as_uint(rm),__float_as_uint(rm),false,false); rm=__builtin_fmaxf(__uint_as_float(rr[0]),__uint_as_float(rr[1])); } \
      resc=false; \
      if(__builtin_expect(__any(rm>(float)THRL),0)){ const float dl=__builtin_fmaxf(rm,0.f); mhat+=dl; \
        _Pragma("unroll") for(int r=0;r<16;++r){C0[r]-=dl;C1[r]-=dl;} \
        const float f=__builtin_amdgcn_exp2f(-dl); l_reg*=f; if(hi==0)wsf[r32]=f; resc=true; } } \
    SBAR(); \
    GAPB(o[0]=__builtin_amdgcn_mfma_f32_32x32x16_bf16(PAF(0),VFR(0),o[0],0,0,0), C0,0); \
    GAPB(o[1]=__builtin_amdgcn_mfma_f32_32x32x16_bf16(PAF(0),VFR(4),o[1],0,0,0), C0,4); \
    KRD(GL,0); GAPB(o[0]=__builtin_amdgcn_mfma_f32_32x32x16_bf16(PAF(1),VFR(1),o[0],0,0,0), C0,8); \
    KRD(GL,1); GAPB(o[1]=__builtin_amdgcn_mfma_f32_32x32x16_bf16(PAF(1),VFR(5),o[1],0,0,0), C0,12); \
    KRD(GL,2); GAPB(o[0]=__builtin_amdgcn_mfma_f32_32x32x16_bf16(PAF(2),VFR(2),o[0],0,0,0), C1,0); \
    KRD(GL,3); GAPB(o[1]=__builtin_amdgcn_mfma_f32_32x32x16_bf16(PAF(2),VFR(6),o[1],0,0,0), C1,4); \
    GAPB(o[0]=__builtin_amdgcn_mfma_f32_32x32x16_bf16(PAF(3),VFR(3),o[0],0,0,0), C1,8); \
    GAPB(o[1]=__builtin_amdgcn_mfma_f32_32x32x16_bf16(PAF(3),VFR(7),o[1],0,0,0), C1,12); \
    }while(0)
  int t=1;
  #undef CMASK
  #define CMASK(P0,P1,t) do{}while(0)
  for(;t+5<NT;t+=2){
    STEP(pB0,pB1,pA0,pA1,t,true,true,true);     WAIT_BAR(2); RESC(); ROT();
    STEP(pA0,pA1,pB0,pB1,t+1,true,true,true);   WAIT_BAR(2); RESC(); ROT();
  }
  #undef CMASK
  #define CMASK(P0,P1,t) do{int jb_=(t)-(NT-4); if(jb_>=0)cmask(P0,P1,jb_,qrel,hi);}while(0)
  #define ENDW(tt) do{ if((tt)+3<NT){WAIT_BAR(2);} else if((tt)+2<NT){WAIT_BAR(1);} else {WAIT_BAR(0);} }while(0)
  for(;t+1<NT;t+=2){
    STEP(pB0,pB1,pA0,pA1,t,(t+3<NT),(t+1<NT),(t+1<NT));       ENDW(t);   RESC(); ROT();
    STEP(pA0,pA1,pB0,pB1,t+1,(t+4<NT),(t+2<NT),(t+2<NT));     ENDW(t+1); RESC(); ROT();
  }
  STEP(pB0,pB1,pA0,pA1,NT-1,false,false,false); RESC();
  { float sacc=pB0[0]+pB0[1]; _Pragma("unroll") for(int r=2;r<16;++r)sacc+=pB0[r]; _Pragma("unroll") for(int r=0;r<16;++r)sacc+=pB1[r]; l_reg+=sacc;
    pw0=(u32x4){PKW(pB0,0),PKW(pB0,2),PKW(pB0,4),PKW(pB0,6)};pw1=(u32x4){PKW(pB0,8),PKW(pB0,10),PKW(pB0,12),PKW(pB0,14)};pw2=(u32x4){PKW(pB1,0),PKW(pB1,2),PKW(pB1,4),PKW(pB1,6)};pw3=(u32x4){PKW(pB1,8),PKW(pB1,10),PKW(pB1,12),PKW(pB1,14)};
    SBAR(); pv(o,vb0+sl_cur,PAF(0),PAF(1),PAF(2),PAF(3)); }
  #undef PKW
  #undef PAF
  #undef VFR
  #undef PIN
  #undef MX3
  #undef GAPA
  #undef GAPB
  #undef EX
  #undef VRD
  #undef KRD
  #undef STEP
  #undef ENDW
  {auto rr=__builtin_amdgcn_permlane32_swap(__float_as_uint(l_reg),__float_as_uint(l_reg),false,false);l_reg=__uint_as_float(rr[0])+__uint_as_float(rr[1]);}
  if(hi==0)wsf[32+r32]=l_reg;asm volatile("s_waitcnt lgkmcnt(0)":::"memory");
  float rli[16];
  #pragma unroll
  for(int r=0;r<16;++r)rli[r]=__builtin_amdgcn_rcpf(wsf[32+crow(r,hi)]);
  bf16*Ow=MIX+(rowbase+q0+wid*QBLK)*MIXP+h*D;
  { bf16*stg=(bf16*)(shm+LDS_OST)+wid*2048;
    #pragma unroll
    for(int r=0;r<16;++r){const int orow=crow(r,hi);
      #pragma unroll
      for(int d0=0;d0<2;++d0)stg[orow*64+d0*32+r32]=__float2bfloat16(o[d0][r]*rli[r]);}
    asm volatile("s_waitcnt lgkmcnt(0)":::"memory");
    const int ch=lane&7; const f32x4_t g0=*(const f32x4_t*)(gain+h*D+ch*8),g1=*(const f32x4_t*)(gain+h*D+ch*8+4);
    #pragma unroll
    for(int i=0;i<4;++i){const int row=i*8+(lane>>3); const u32x4 v=*(const u32x4*)(stg+row*64+ch*8);
      const float f0=__uint_as_float(v.x<<16),f1=__uint_as_float(v.x&0xffff0000u),f2=__uint_as_float(v.y<<16),f3=__uint_as_float(v.y&0xffff0000u),f4=__uint_as_float(v.z<<16),f5=__uint_as_float(v.z&0xffff0000u),f6=__uint_as_float(v.w<<16),f7=__uint_as_float(v.w&0xffff0000u);
      float ss=((f0*f0+f1*f1)+(f2*f2+f3*f3))+((f4*f4+f5*f5)+(f6*f6+f7*f7)); ss=pg8::add_xor1(ss); ss=pg8::add_xor2(ss); ss=pg8::add_xor4(ss);
      const float rs=rsqrtf(ss*(1.0f/64.0f)+1e-6f);
      u32x4 w; w.x=cvtpk_s(f0*rs*g0[0],f1*rs*g0[1]); w.y=cvtpk_s(f2*rs*g0[2],f3*rs*g0[3]); w.z=cvtpk_s(f4*rs*g1[0],f5*rs*g1[1]); w.w=cvtpk_s(f6*rs*g1[2],f7*rs*g1[3]);
      ATTN_STORE16(Ow+(long)row*MIXP+ch*8,w);} }
  asm volatile("s_waitcnt lgkmcnt(0)\n\ts_barrier":::"memory");
  #undef BIAS
  #undef DMA_K
  #undef DMA_V
  #undef CMASK
  #undef START
  #undef RESC
  #undef ROT
}
constexpr int ATTN_LDS_BYTES=LDS_BYTES;
struct AttnTensors { const bf16* Q; const bf16* K; const bf16* V; const float* C; const float* gain; bf16* MIX; };
struct AttnUnit { int bh; int qb; };
struct StaticOrder {
  int vcu,G;
  __device__ __forceinline__ explicit StaticOrder(int grid,int block):vcu((grid%8==0)?(block%8)*(grid/8)+block/8:block),G(grid){}
  __device__ __forceinline__ bool next(int i,AttnUnit&u)const{ const int pair=vcu+(i>>1)*G; if(pair>=BATCH*NHEAD*4)return false; const int s=pair&3; u.bh=pair>>2; u.qb=(i&1)?s:7-s; return true; }
  __device__ __forceinline__ void a_ready(const AttnUnit&)const{}
  __device__ __forceinline__ void done(const AttnUnit&)const{}
};
template<class Sched,int THRL=8> __device__ __forceinline__ void attn_phase(char*lds,const AttnTensors&T,const Sched&S,int tid_in){
  AttnUnit u;
  for(int i=0;S.next(i,u);++i){ S.a_ready(u); attn_unit<THRL>(u.bh/NHEAD,u.bh%NHEAD,u.qb,T.Q,T.K,T.V,T.C+(long)u.bh*SEQ,T.gain,T.MIX,lds,tid_in); S.done(u); }
}
#undef SBAR
#undef WAIT_BAR
}
#define GAS __attribute__((address_space(1)))
#define LAS __attribute__((address_space(3)))
typedef unsigned short bf16;
typedef unsigned v4u __attribute__((ext_vector_type(4)));
typedef float f32x4 __attribute__((ext_vector_type(4)));
typedef short bf16x8 __attribute__((ext_vector_type(8)));
typedef GAS unsigned gu32;
typedef GAS unsigned long long gu64;
#define RLX_AGENT __ATOMIC_RELAXED, __HIP_MEMORY_SCOPE_AGENT
#define LDS_WAIT() asm volatile("s_waitcnt lgkmcnt(0)" ::: "memory")
#define VM_WAIT() asm volatile("s_waitcnt vmcnt(0)" ::: "memory")
__device__ __forceinline__ unsigned long long rt() { return __builtin_amdgcn_s_memrealtime(); }
__device__ __forceinline__ unsigned f2bf(float f) { unsigned u = __builtin_bit_cast(unsigned, f); return (u + 0x7fffu + ((u >> 16) & 1u)) >> 16; }
__device__ __forceinline__ unsigned pk2(float lo, float hi) { return f2bf(lo) | (f2bf(hi) << 16); }

#define XB_TMO      128
#define XB_XCNT(j)  (256  + 64 * (j))
#define XB_XSUB(j)  (1280 + 64 * (j))
#define XB_XGEN(j)  (2304 + 64 * (j))
#define XB_TOP      3328
#define XB_TOPGEN   3392
#define XCD_BAR_WORDS 3456
#define XB_SPIN_CAP (1u << 18)

__device__ __forceinline__ unsigned xb_ld(unsigned* p)              { return __hip_atomic_load(p, __ATOMIC_RELAXED, __HIP_MEMORY_SCOPE_AGENT); }
__device__ __forceinline__ unsigned xb_add(unsigned* p, unsigned v) { return __hip_atomic_fetch_add(p, v, __ATOMIC_RELAXED, __HIP_MEMORY_SCOPE_AGENT); }
__device__ __forceinline__ unsigned xb_xcc_id() { return (unsigned)__builtin_amdgcn_s_getreg((3 << 11) | 20) & 0xFu; }
#define XB_SPIN(cond, bar) do { unsigned _sp = 0; while (cond) { __builtin_amdgcn_s_sleep(1); \
    if ((++_sp & 255u) == 0u) { if (xb_ld(&(bar)[XB_TMO])) break; if (_sp > XB_SPIN_CAP) { atomicAdd(&(bar)[XB_TMO], 1u); break; } } } } while (0)

struct XcdBarrier {
    unsigned* bar; unsigned x;
    volatile LAS unsigned* st;
};

__device__ __forceinline__ int lane_id_volatile() { int l; asm volatile("v_mbcnt_lo_u32_b32 %0, -1, 0\n\tv_mbcnt_hi_u32_b32 %0, -1, %0" : "=v"(l)); return l; }
__device__ __forceinline__ bool xb_t0(int wave) { return wave == 0 && lane_id_volatile() == 0; }
__device__ __forceinline__ XcdBarrier xcd_barrier_post(unsigned* bar, volatile LAS unsigned* st, int wave) {
    XcdBarrier b; b.bar = bar; b.x = xb_xcc_id(); b.st = st;
    if (xb_t0(wave)) (void)xb_add(&bar[XB_XCNT(b.x)], 1u);
    return b;
}
__device__ __forceinline__ void xcd_barrier_complete(unsigned* bar, unsigned x, unsigned& nloc, unsigned& nx) {
    const unsigned G = gridDim.x * gridDim.y * gridDim.z;
    unsigned sum, cnt, mine, sp = 0u;
    for (;;) {
        sum = 0u; cnt = 0u; mine = 0u;
#pragma unroll
        for (unsigned j = 0; j < 16; ++j) { const unsigned c = xb_ld(&bar[XB_XCNT(j)]); sum += c; cnt += (c > 0u) ? 1u : 0u; mine = (j == x) ? c : mine; }
        if (sum == G) break;
        __builtin_amdgcn_s_sleep(1);
        if ((++sp & 255u) == 0u) { if (xb_ld(&bar[XB_TMO])) break; if (sp > XB_SPIN_CAP) { atomicAdd(&bar[XB_TMO], 1u); break; } }
    }
    nloc = mine > 0u ? mine : 1u; nx = cnt > 0u ? cnt : 1u;
}

__device__ __forceinline__ void xcd_barrier(const XcdBarrier& b, int wave) {
    asm volatile("s_waitcnt vmcnt(0)" ::: "memory");
    __syncthreads();
    if (xb_t0(wave)) {
        unsigned* bar = b.bar;
        __builtin_amdgcn_s_waitcnt(0);
        unsigned nloc = b.st[0], nx = b.st[1];
        if (nloc == 0u) { xcd_barrier_complete(bar, b.x, nloc, nx); b.st[0] = nloc; b.st[1] = nx; }
        const unsigned old = xb_add(&bar[XB_XSUB(b.x)], 1u);
        const unsigned gen = old / nloc;
        if (old + 1u == (gen + 1u) * nloc) {
            __builtin_amdgcn_fence(__ATOMIC_RELEASE, "agent");
            asm volatile("s_waitcnt vmcnt(0)" ::: "memory");
            const unsigned og = xb_add(&bar[XB_TOP], 1u);
            const unsigned tg = og / nx;
            if (og + 1u == (tg + 1u) * nx) xb_add(&bar[XB_TOPGEN], 1u);
            else XB_SPIN(xb_ld(&bar[XB_TOPGEN]) == tg, bar);
            __builtin_amdgcn_fence(__ATOMIC_ACQUIRE, "agent");
            xb_add(&bar[XB_XGEN(b.x)], 1u);
            asm volatile("s_waitcnt vmcnt(0)" ::: "memory");
        } else {
            XB_SPIN(xb_ld(&bar[XB_XGEN(b.x)]) == gen, bar);
            __builtin_amdgcn_fence(__ATOMIC_ACQUIRE, "agent");
            asm volatile("s_waitcnt vmcnt(0)" ::: "memory");
        }
    }
    __syncthreads();
}
template <class Idle> __device__ __forceinline__ void xcd_barrier_idle(const XcdBarrier& b, int wave, Idle idle) {
    asm volatile("s_waitcnt vmcnt(0)" ::: "memory");
    __syncthreads();
    if (xb_t0(wave)) {
        unsigned* bar = b.bar;
        __builtin_amdgcn_s_waitcnt(0);
        unsigned nloc = b.st[0], nx = b.st[1];
        if (nloc == 0u) { xcd_barrier_complete(bar, b.x, nloc, nx); b.st[0] = nloc; b.st[1] = nx; }
        const unsigned old = xb_add(&bar[XB_XSUB(b.x)], 1u);
        const unsigned gen = old / nloc;
        if (old + 1u == (gen + 1u) * nloc) {
            __builtin_amdgcn_fence(__ATOMIC_RELEASE, "agent");
            asm volatile("s_waitcnt vmcnt(0)" ::: "memory");
            const unsigned og = xb_add(&bar[XB_TOP], 1u);
            const unsigned tg = og / nx;
            if (og + 1u == (tg + 1u) * nx) xb_add(&bar[XB_TOPGEN], 1u);
            else XB_SPIN(xb_ld(&bar[XB_TOPGEN]) == tg, bar);
            __builtin_amdgcn_fence(__ATOMIC_ACQUIRE, "agent");
            xb_add(&bar[XB_XGEN(b.x)], 1u);
            asm volatile("s_waitcnt vmcnt(0)" ::: "memory");
        } else {
            XB_SPIN(xb_ld(&bar[XB_XGEN(b.x)]) == gen, bar);
            __builtin_amdgcn_fence(__ATOMIC_ACQUIRE, "agent");
            asm volatile("s_waitcnt vmcnt(0)" ::: "memory");
        }
    } else if (wave != 0) idle();
    __syncthreads();
}
constexpr int NWAVES = 8;
constexpr int BATCH = 8, SEQ = 2048, M = BATCH * SEQ, D = 1024, DEPTH = 4, DPLE = 256, HD = 64, NHEAD = 8;
constexpr int DIN = 3592, NIN = 3840  , DFF = 2816, NE = 8, DEXP = 3584;
constexpr int SLOTS = 2 * M + NE * 256;
constexpr float C2 = 0.125f * 1.4426950408889634f;
constexpr float LN2 = 0.6931471805599453f;
constexpr float F8_SX = 4.f, F8_SWU = 64.f, F8_SH = 8.f, F8_SWD = 128.f;
static_assert(F8_SX == 4.f && F8_SH * F8_SWD == 1024.f, "EpiRes template exponents in the step program assume these");


constexpr size_t MiB = 1u << 20;
constexpr size_t WS_CTL = 0, CTL_ZERO_BYTES = 1 * MiB;
constexpr size_t WS_WIN = 1 * MiB;
constexpr size_t WS_WOUT = WS_WIN + 4 * (size_t)NIN * D * 2;
constexpr size_t WS_WPLE = WS_WOUT + 4 * (size_t)D * D * 2;
constexpr size_t WS_WPG = WS_WPLE + 4 * (size_t)D * DPLE * 2;
constexpr size_t WS_WGU = WS_WPG + 4 * (size_t)D * D * 2;
constexpr size_t WS_WD = WS_WGU + 2 * (size_t)2 * DFF * D * 2;
constexpr size_t WS_WEGU = WS_WD + 2 * (size_t)D * DFF * 2;
constexpr size_t WS_WED = WS_WEGU + 2 * (size_t)NE * 2 * DEXP * D * 2;
constexpr size_t WS_WR = WS_WED + 2 * (size_t)NE * D * DEXP * 2;
constexpr size_t WS_LB = WS_WR + 2 * (size_t)NE * D * 4;
constexpr size_t WS_META = WS_LB + 4 * 512 * 4;
constexpr size_t WS_H = ((WS_META + 256 + MiB - 1) / MiB) * MiB;
constexpr size_t WS_H8 = WS_H;
constexpr size_t WS_HB = WS_H + (size_t)M * D * 4;
constexpr size_t WS_SSQ = WS_HB + (size_t)M * D * 2;
constexpr size_t WS_PB = WS_SSQ + 2 * (size_t)M * 16 * 4;
constexpr size_t WS_P2 = WS_PB + (size_t)DEPTH * M * DPLE * 2;
constexpr size_t WS_TOKE = WS_P2 + (size_t)M * D * 2;
constexpr size_t WS_TOKW = WS_TOKE + (size_t)M * 8;
constexpr size_t WS_RANK = WS_TOKW + (size_t)M * 8;
constexpr size_t WS_SLOT = WS_RANK + (size_t)M * 8;
constexpr size_t WS_RSTD = WS_SLOT + (size_t)M * 8;
constexpr size_t WS_BCNT = WS_RSTD + (size_t)M * 4;
constexpr size_t WS_PLOG = ((WS_BCNT + 8192 + MiB - 1) / MiB) * MiB;
constexpr size_t WS_SCR = WS_PLOG + (size_t)M * 16 * 8 * 4;
constexpr size_t WS_ZB = WS_SCR;
constexpr size_t ZARR = (size_t)M * 512;
constexpr size_t WS_FG = WS_ZB + 7 * ZARR * 2;
constexpr size_t WS_CB = WS_FG + (size_t)M * 8 * 4;
constexpr size_t WS_MIX = WS_CB + (size_t)M * 8 * 4;
constexpr size_t WS_HL = WS_MIX + (size_t)M * D * 2;
constexpr size_t WS_HS = WS_HL + (size_t)2048 * 4096 * 4;
constexpr size_t WS_HG_ = WS_HS + (size_t)2048 * 4096 * 4;
constexpr size_t WS_MIX_END = WS_HG_ + (size_t)2048 * 64 * 4;
constexpr size_t WS_ACT = WS_SCR;
constexpr size_t WS_XG = WS_SCR;
constexpr size_t WS_HGB = WS_XG + (size_t)SLOTS * D * 2;
constexpr size_t WS_YP = WS_HGB + (size_t)SLOTS * DEXP * 2;
constexpr size_t YP_TILES = 256;
constexpr size_t WS_END = (WS_YP + YP_TILES * 65536 * 2 > WS_MIX_END) ? WS_YP + YP_TILES * 65536 * 2 : WS_MIX_END;
constexpr int CW_BAR = 4096, MAX_BAR_REGIONS = 64;
static_assert((CW_BAR + MAX_BAR_REGIONS * 3456) * 4 <= (int)CTL_ZERO_BYTES, "ctl");

constexpr int RING_OFF = 0, RING_BYTES = 131072;
constexpr int LDSCTL_OFF = RING_BYTES, MISC_OFF = LDSCTL_OFF + 320;
constexpr int LDS_BYTES = 147456;

struct Args { const float* in[21]; float* out; unsigned char* ws; int s_lo, s_hi, li, pad; };
typedef const __attribute__((address_space(4))) Args KArgs;
#define KIN(F, k) ((const float*)(const GAS float*)(F).ka->in[k])
struct Frame {
    LAS unsigned char* lds; volatile LAS unsigned* MISC;
    int tid, lane, wave, G, gw, NGW, bx;
    const KArgs* ka; float* out; GAS unsigned char* ws;
};
template <int CTRL, int ROWM> __device__ __forceinline__ float dpp0(float v) { return __builtin_bit_cast(float, __builtin_amdgcn_update_dpp(0, __builtin_bit_cast(int, v), CTRL, ROWM, 0xf, true)); }
__device__ __forceinline__ float wave_incl_scan(float v) {
    v += dpp0<0x111, 0xf>(v); v += dpp0<0x112, 0xf>(v); v += dpp0<0x114, 0xf>(v); v += dpp0<0x118, 0xf>(v);
    v += dpp0<0x142, 0xa>(v);
    v += dpp0<0x143, 0xc>(v);
    return v;
}
__device__ __forceinline__ float wave_sum(float v) { return __builtin_bit_cast(float, __builtin_amdgcn_readlane(__builtin_bit_cast(int, wave_incl_scan(v)), 63)); }
__device__ __forceinline__ f32x4 ldh4(const bf16* p) { const unsigned long long a = *(const unsigned long long*)p; f32x4 r; r[0] = __uint_as_float((unsigned)a << 16); r[1] = __uint_as_float((unsigned)a & 0xffff0000u); r[2] = __uint_as_float((unsigned)(a >> 32) << 16); r[3] = __uint_as_float((unsigned)(a >> 32) & 0xffff0000u); return r; }
__device__ __forceinline__ f32x4 ldh4nt(const bf16* p) { const unsigned long long a = __builtin_nontemporal_load((const unsigned long long*)p); f32x4 r; r[0] = __uint_as_float((unsigned)a << 16); r[1] = __uint_as_float((unsigned)a & 0xffff0000u); r[2] = __uint_as_float((unsigned)(a >> 32) << 16); r[3] = __uint_as_float((unsigned)(a >> 32) & 0xffff0000u); return r; }
__device__ __forceinline__ float log_sigmoid_f(float x) { return fminf(x, 0.f) - 0.6931471805599453f * __builtin_amdgcn_logf(1.f + __builtin_amdgcn_exp2f(-1.4426950408889634f * fabsf(x))); }

__device__ __forceinline__ void tr_item(const float* src, int ld, const float* gain, bf16* dst, int dK, LAS float* scr, int lane) {
    float vr[32];
    { const float* p = src + (size_t)(lane >> 5) * ld + (lane & 31); const size_t st = (size_t)2 * ld;
#pragma unroll
      for (int i = 0; i < 32; ++i) { vr[i] = MK_NT ? __builtin_nontemporal_load(p) : *p; p += st; } }
    if (gain) { const float* gp = gain + (lane >> 5);
#pragma unroll
        for (int i = 0; i < 32; ++i) vr[i] *= gp[2 * i]; }
#pragma unroll
    for (int i = 0; i < 32; ++i) scr[(2 * i + (lane >> 5)) * 33 + (lane & 31)] = vr[i];
    LDS_WAIT(); asm volatile("" ::: "memory");
    const int c = lane & 7;
#pragma unroll
    for (int j = 0; j < 4; ++j) { const int n = (lane >> 3) + 8 * j; const LAS float* s = scr + (8 * c) * 33 + n;
        v4u o; o.x = pg8::cvt_pk_bf16(s[0 * 33], s[1 * 33]); o.y = pg8::cvt_pk_bf16(s[2 * 33], s[3 * 33]); o.z = pg8::cvt_pk_bf16(s[4 * 33], s[5 * 33]); o.w = pg8::cvt_pk_bf16(s[6 * 33], s[7 * 33]);
        if (MK_NT) __builtin_nontemporal_store(o, (GAS v4u*)(dst + (size_t)n * dK + 8 * c)); else *(GAS v4u*)(dst + (size_t)n * dK + 8 * c) = o; }
    LDS_WAIT(); asm volatile("" ::: "memory");
}
__device__ __forceinline__ void tr_item8(const float* src, int ld, const float* gain, float scale, unsigned char* dst8, int dK, LAS float* scr, int lane) {
    float vr[32];
    { const float* p = src + (size_t)(lane >> 5) * ld + (lane & 31); const size_t st = (size_t)2 * ld;
#pragma unroll
      for (int i = 0; i < 32; ++i) { vr[i] = MK_NT ? __builtin_nontemporal_load(p) : *p; p += st; } }
    if (gain) { const float* gp = gain + (lane >> 5);
#pragma unroll
        for (int i = 0; i < 32; ++i) vr[i] *= gp[2 * i]; }
#pragma unroll
    for (int i = 0; i < 32; ++i) scr[(2 * i + (lane >> 5)) * 33 + (lane & 31)] = vr[i] * scale;
    LDS_WAIT(); asm volatile("" ::: "memory");
    const int c = lane & 7;
#pragma unroll
    for (int j = 0; j < 4; ++j) { const int n = (lane >> 3) + 8 * j; const LAS float* s = scr + (8 * c) * 33 + n;
        const unsigned lo = pg8::pack4_fp8(s[0 * 33], s[1 * 33], s[2 * 33], s[3 * 33]), hi = pg8::pack4_fp8(s[4 * 33], s[5 * 33], s[6 * 33], s[7 * 33]);
        if (MK_NT) __builtin_nontemporal_store((unsigned long long)lo | ((unsigned long long)hi << 32), (GAS unsigned long long*)(dst8 + (size_t)n * dK + 8 * c)); else *(GAS unsigned long long*)(dst8 + (size_t)n * dK + 8 * c) = (unsigned long long)lo | ((unsigned long long)hi << 32); }
    LDS_WAIT(); asm volatile("" ::: "memory");
}
__device__ __forceinline__ void tr_job(const float* W, int K, int ld, int c0, int nc, const float* gain, bf16* dst, int IL, int iloff, int item, LAS float* scr, int lane, float f8scale) {
    const int nblk = nc / 32, kb = item / nblk, nb = item % nblk, k0 = 64 * kb, n0 = 32 * nb;
    const int orow = (IL ? 256 * (n0 / 128) + (n0 % 128) : n0) + iloff;
    if (f8scale != 0.f) tr_item8(W + (size_t)k0 * ld + c0 + n0, ld, gain ? gain + k0 : nullptr, f8scale, (unsigned char*)dst + (size_t)orow * K + k0, K, scr, lane);
    else tr_item(W + (size_t)k0 * ld + c0 + n0, ld, gain ? gain + k0 : nullptr, dst + (size_t)orow * K + k0, K, scr, lane);
}
namespace cv {
constexpr int I_INA = 16 * 48, I_INB = 16 * 64, I_OUT = 16 * 32, I_PLE = 4 * 32, I_PG = 16 * 32, I_FG = 16 * 88, I_FD = 44 * 32, I_EG = 16 * 112, I_ED = 56 * 32;
constexpr int T_L = I_INA + I_INB + I_OUT + I_PLE + I_PG;
constexpr int T_F = 2 * I_FG + I_FD;
constexpr int T_E = 2 * I_EG + I_ED;
constexpr int NITEMS = 4 * T_L + 2 * T_F + 16 * T_E;
constexpr int E3_LO = 8 * T_E;
constexpr int Q_IN0 = MK_Q_IN, Q_IN1 = MK_Q_IN, Q_IN2 = MK_Q_IN, Q_IN3 = F8IN(3) ? MK_Q_IN8 : MK_Q_IN;
constexpr int Q_UP0 = F8DENSE(0) ? MK_Q_UP8 : MK_Q_UP, Q_UP2 = F8DENSE(1) ? MK_Q_UP8 : MK_Q_UP, Q_MUP = 6500;
constexpr int D1A = Q_IN0, D1B = D1A + Q_IN1, D1N = D1B + Q_UP0;
constexpr int Q_SC = MK_Q_SC;
constexpr int QB = MK_QB, NB1 = 15, NB3 = 19;
constexpr int D3A = Q_IN2, D3B = D3A + Q_IN3, D3C = D3B + Q_UP2, D3N = D3C + Q_MUP;
static_assert(D1N <= E3_LO && D3N <= E3_LO, "deferred ranges");
constexpr int BAR1 = D1N + 2 * Q_SC, BAR3 = E3_LO + D3N + 2 * Q_SC;
static_assert(BAR1 <= E3_LO && BAR3 <= 16 * T_E && QB % 256 == 0 && QB <= 1536, "deferred ranges");
__device__ __forceinline__ void bar_range(int step, int& lo, int& hi) {
    if (step < NB1) { lo = BAR1 + step * QB; hi = lo + QB < E3_LO ? lo + QB : E3_LO; }
    else if (step < NB1 + NB3) { lo = BAR3 + (step - NB1) * QB; hi = lo + QB < 16 * T_E ? lo + QB : 16 * T_E; }
    else { lo = 0; hi = 0; }
}
}
__device__ __forceinline__ void conv_item(Frame& F, int it, LAS float* scr, int lane) {
    using namespace cv;
    const float *w_in = KIN(F, 2), *w_out = KIN(F, 7), *mix_gain = KIN(F, 8), *ffn_gain = KIN(F, 9), *ple_gain = KIN(F, 10), *w_fg = KIN(F, 11), *w_fu = KIN(F, 12), *w_fd = KIN(F, 13),
                *w_router = KIN(F, 14), *w_eg = KIN(F, 15), *w_eu = KIN(F, 16), *w_ed = KIN(F, 17), *w_ple = KIN(F, 18), *w_pg = KIN(F, 19);
    bf16* Win = (bf16*)(F.ws + WS_WIN); bf16* Wout = (bf16*)(F.ws + WS_WOUT); bf16* Wple = (bf16*)(F.ws + WS_WPLE); bf16* Wpg = (bf16*)(F.ws + WS_WPG);
    bf16* Wgu = (bf16*)(F.ws + WS_WGU); bf16* Wd = (bf16*)(F.ws + WS_WD); bf16* Wegu = (bf16*)(F.ws + WS_WEGU); bf16* Wed = (bf16*)(F.ws + WS_WED);
        int r = it; const float* W; int K, ld, c0, nc, IL = 0, iloff = 0; const float* g = nullptr; bf16* dst;
        float f8s = 0.f;
        if (r < 16 * T_E) { const int je = r / T_E, j = je / 8; r %= T_E; K = D; ld = DEXP; c0 = 0; nc = DEXP; g = ffn_gain + (2 * j + 1) * D; dst = Wegu + (size_t)je * 2 * DEXP * D; IL = 1;
            const bool f8 = MK_FP8_LAST && (j == 1 || MK_FP8_L1);
            if (f8) { dst = (bf16*)((unsigned char*)(Wegu + (size_t)j * 8 * 2 * DEXP * D) + (size_t)(je - 8 * j) * 2 * DEXP * D); f8s = F8_SWU; }
            if (r < I_EG) { W = w_eg + (size_t)je * D * DEXP; }
            else if (r < 2 * I_EG) { r -= I_EG; W = w_eu + (size_t)je * D * DEXP; iloff = 128; }
            else { r -= 2 * I_EG; W = w_ed + (size_t)je * DEXP * D; K = DEXP; ld = D; nc = D; g = nullptr; dst = Wed + (size_t)je * D * DEXP; IL = 0;
                if (f8) { dst = (bf16*)((unsigned char*)(Wed + (size_t)j * 8 * D * DEXP) + (size_t)(je - 8 * j) * D * DEXP); f8s = F8_SWD; } } }
        else if (r < 16 * T_E + 2 * T_F) { r -= 16 * T_E; const int j = r / T_F; r %= T_F; K = D; ld = DFF; c0 = 0; nc = DFF; g = ffn_gain + (2 * j) * D; dst = Wgu + (size_t)j * 2 * DFF * D; IL = 1;
            if (F8DENSE(j)) f8s = F8_SWU;
            if (r < I_FG) { W = w_fg + (size_t)j * D * DFF; }
            else if (r < 2 * I_FG) { r -= I_FG; W = w_fu + (size_t)j * D * DFF; iloff = 128; }
            else { r -= 2 * I_FG; W = w_fd + (size_t)j * DFF * D; K = DFF; ld = D; nc = D; g = nullptr; dst = Wd + (size_t)j * D * DFF; IL = 0; if (F8DENSE(j)) f8s = F8_SWD; } }
        else { r -= 16 * T_E + 2 * T_F; const int i = r / T_L; r %= T_L; K = D; c0 = 0;
            if (r < I_INA) { W = w_in + (size_t)i * D * DIN; ld = DIN; nc = 1536; g = mix_gain + i * D; dst = Win + (size_t)i * NIN * D; if (F8IN(i)) f8s = F8_SWU; }
            else if (r < I_INA + I_INB) { r -= I_INA; W = w_in + (size_t)i * D * DIN; ld = DIN; c0 = 1544; nc = 2048; g = mix_gain + i * D; dst = Win + (size_t)i * NIN * D; iloff = 1536; if (F8IN(i)) f8s = F8_SWU; }
            else if (r < I_INA + I_INB + I_OUT) { r -= I_INA + I_INB; W = w_out + (size_t)i * D * D; ld = D; nc = D; dst = Wout + (size_t)i * D * D; }
            else if (r < I_INA + I_INB + I_OUT + I_PLE) { r -= I_INA + I_INB + I_OUT; W = w_ple + (size_t)i * DPLE * D; K = DPLE; ld = D; nc = D; dst = Wple + (size_t)i * D * DPLE; }
            else { r -= I_INA + I_INB + I_OUT + I_PLE; W = w_pg + (size_t)i * D * D; ld = D; nc = D; g = ple_gain + i * D; dst = Wpg + (size_t)i * D * D; } }
        tr_job(W, K, ld, c0, nc, g, dst, IL, iloff, r, scr, lane, f8s);
}
__device__ __forceinline__ void conv_range(Frame& F, int lo, int hi, int rank, int nranks) {
    LAS float* scr = (LAS float*)(F.lds + RING_OFF + F.wave * 16384);
    for (int it = lo + rank * NWAVES + F.wave; it < hi; it += nranks * NWAVES) conv_item(F, it, scr, F.lane);
}
constexpr int PB_SHARES = 17;
__device__ __forceinline__ void pb_barrier_share(Frame& F, int step, int lane) {
    const float* p = KIN(F, 1); bf16* pb = (bf16*)(F.ws + WS_PB);
    constexpr size_t C0 = (size_t)M * DPLE / 8, NC = 3 * C0, PER = (NC + PB_SHARES - 1) / PB_SHARES;
    const size_t lo = C0 + (size_t)step * PER, hi = (lo + PER < C0 + NC) ? lo + PER : C0 + NC;
    for (size_t idx = lo + (size_t)(F.bx * 2 + (F.wave - 2)) * 64 + lane; idx < hi; idx += (size_t)256 * 2 * 64) { const f32x4 a = __builtin_nontemporal_load((const f32x4*)(p + idx * 8)), b = __builtin_nontemporal_load((const f32x4*)(p + idx * 8 + 4));
        v4u o; o.x = pg8::cvt_pk_bf16(a[0], a[1]); o.y = pg8::cvt_pk_bf16(a[2], a[3]); o.z = pg8::cvt_pk_bf16(b[0], b[1]); o.w = pg8::cvt_pk_bf16(b[2], b[3]); *(v4u*)(pb + idx * 8) = o; }
}
__device__ __forceinline__ void p0_prologue(Frame& F) {
    using namespace cv;
    const int gw = F.gw, NGW = F.NGW, lane = F.lane;
    const float *w_in = KIN(F, 2), *mix_gain = KIN(F, 8), *ffn_gain = KIN(F, 9), *w_router = KIN(F, 14);
    bf16* Win = (bf16*)(F.ws + WS_WIN);
    { LAS float* scr = (LAS float*)(F.lds + RING_OFF + F.wave * 16384);
      if (F.G == 256) {
          constexpr int S1 = (BAR1 + NB1 * QB < E3_LO) ? BAR1 + NB1 * QB : E3_LO, S2 = (BAR3 + NB3 * QB < 16 * T_E) ? BAR3 + NB3 * QB : 16 * T_E, N1 = E3_LO - S1, N2 = NITEMS - S2;
          static_assert(N1 >= 0 && N2 >= 0, "deferred ranges");
          for (int k = gw; k < N1 + N2; k += NGW) conv_item(F, k < N1 ? S1 + k : S2 + (k - N1), scr, lane);
      } else { for (int it = gw; it < NITEMS; it += NGW) conv_item(F, it, scr, lane); } }
    const int gt = gw * 64 + lane, NGT = NGW * 64;
    for (int idx = gt; idx < 4 * 256 * 128; idx += NGT) { const int i = idx / (256 * 128), rr = (idx / 128) % 256, kc = (idx % 128) * 8; float v[8];
#pragma unroll
        for (int q = 0; q < 8; ++q) v[q] = (rr < 8) ? w_in[(size_t)i * D * DIN + (size_t)(kc + q) * DIN + 1536 + rr] * mix_gain[i * D + kc + q] : 0.f;
        if (F8IN(i)) { pg8::u32x2 o8; o8.x = pg8::pack4_fp8(v[0] * F8_SWU, v[1] * F8_SWU, v[2] * F8_SWU, v[3] * F8_SWU); o8.y = pg8::pack4_fp8(v[4] * F8_SWU, v[5] * F8_SWU, v[6] * F8_SWU, v[7] * F8_SWU);
            *(pg8::u32x2*)((unsigned char*)(Win + (size_t)i * NIN * D) + (size_t)(3584 + rr) * D + kc) = o8; }
        else { v4u o; o.x = pg8::cvt_pk_bf16(v[0], v[1]); o.y = pg8::cvt_pk_bf16(v[2], v[3]); o.z = pg8::cvt_pk_bf16(v[4], v[5]); o.w = pg8::cvt_pk_bf16(v[6], v[7]);
        *(v4u*)(Win + (size_t)i * NIN * D + (size_t)(3584 + rr) * D + kc) = o; } }
    { float* wr = (float*)(F.ws + WS_WR); for (int idx = gt; idx < 2 * NE * D; idx += NGT) { const int j = idx / (NE * D), e = (idx / D) % NE, k = idx % D; wr[idx] = w_router[(size_t)j * D * NE + (size_t)k * NE + e] * ffn_gain[(2 * j + 1) * D + k]; } }
    { float* lb = (float*)(F.ws + WS_LB); const float* lg = KIN(F, 5);
      for (int c = gt; c < 512; c += NGT) { float l[4], mx = -1e30f; for (int i = 0; i < 4; ++i) { l[i] = lg[i * 512 + c]; mx = fmaxf(mx, l[i]); } float s = 0.f; for (int i = 0; i < 4; ++i) { l[i] = __expf(l[i] - mx); s += l[i]; }
          float cum = 0.f; for (int i = 0; i < 4; ++i) { lb[i * 512 + c] = cum; if (i < 3) cum += l[i + 1] / s; } } }
    { const float* p = KIN(F, 1); bf16* pb = (bf16*)(F.ws + WS_PB);
      const size_t npb = (size_t)((F.G == 256 && QB > 0) ? 1 : DEPTH) * M * DPLE / 8;
      for (size_t idx = gt; idx < npb; idx += NGT) { const f32x4 a = __builtin_nontemporal_load((const f32x4*)(p + idx * 8)), b = __builtin_nontemporal_load((const f32x4*)(p + idx * 8 + 4));
          v4u o; o.x = pg8::cvt_pk_bf16(a[0], a[1]); o.y = pg8::cvt_pk_bf16(a[2], a[3]); o.z = pg8::cvt_pk_bf16(b[0], b[1]); o.w = pg8::cvt_pk_bf16(b[2], b[3]); *(v4u*)(pb + idx * 8) = o; } }
    { const float* x = KIN(F, 0); bf16* hb = (bf16*)(F.ws + WS_HB); float* ssq = (float*)(F.ws + WS_SSQ);
      for (int m = gw; m < M; m += NGW) { const f32x4* xr = (const f32x4*)(x + (size_t)m * D) + lane; f32x4 v[4]; float s = 0.f;
#pragma unroll
          for (int j = 0; j < 4; ++j) { v[j] = __builtin_nontemporal_load(xr + 64 * j); s += (v[j][0] * v[j][0] + v[j][1] * v[j][1]) + (v[j][2] * v[j][2] + v[j][3] * v[j][3]); }
          s = wave_sum(s);
          unsigned long long* o8 = (unsigned long long*)(hb + (size_t)m * D) + lane;
#pragma unroll
          for (int j = 0; j < 4; ++j) o8[64 * j] = (unsigned long long)pg8::cvt_pk_bf16(v[j][0], v[j][1]) | ((unsigned long long)pg8::cvt_pk_bf16(v[j][2], v[j][3]) << 32);
          if (lane == 0) ssq[m] = s; }
      for (int i = gt; i < 15 * M / 4; i += NGT) ((f32x4*)(ssq + M))[i] = (f32x4){0.f, 0.f, 0.f, 0.f}; }
}
__device__ __forceinline__ void mall_touch(Frame& F, size_t off, size_t bytes) {
    const size_t step = (size_t)F.NGW * 64 * 128;
    const GAS unsigned char* p = F.ws + off + ((size_t)F.gw * 64 + F.lane) * 128; const GAS unsigned char* end = F.ws + off + bytes;
    for (; p < end; p += 4 * step) { unsigned t0, t1, t2, t3;
        const GAS unsigned char *p1 = p + step < end ? p + step : p, *p2 = p + 2 * step < end ? p + 2 * step : p, *p3 = p + 3 * step < end ? p + 3 * step : p;
        asm volatile("global_load_dword %0, %4, off\n\tglobal_load_dword %1, %5, off\n\tglobal_load_dword %2, %6, off\n\tglobal_load_dword %3, %7, off\n\ts_waitcnt vmcnt(0)"
                     : "=&v"(t0), "=&v"(t1), "=&v"(t2), "=&v"(t3) : "v"(p), "v"(p1), "v"(p2), "v"(p3) : "memory"); }
}
__device__ __forceinline__ void fox_cscan(Frame& F, int layer, int bh) {
    asm volatile("; CSC_BEGIN" ::: "memory");
    const float* fg = (const float*)(F.ws + WS_FG); float* cb = (float*)(F.ws + WS_CB); const float* bias = KIN(F, 3) + layer * NHEAD;
    { const int b = bh / NHEAD, h = bh % NHEAD, lane = F.lane; const float bi = bias[h];
        float x[32];
#pragma unroll
        for (int j = 0; j < 32; ++j) x[j] = fg[(size_t)(b * SEQ + j * 64 + lane) * 8 + h];
        float carry = 0.f;
#pragma unroll
        for (int j = 0; j < 32; ++j) { const float incl = wave_incl_scan(log_sigmoid_f(x[j] + bi)) + carry;
            cb[(size_t)bh * SEQ + j * 64 + lane] = incl;
            carry = __builtin_bit_cast(float, __builtin_amdgcn_readlane(__builtin_bit_cast(int, incl), 63)); } }
}
__device__ __forceinline__ void moe_route_a(Frame& F, int j) {
    asm volatile("; RA_BEGIN" ::: "memory");
    LAS float* wrl = (LAS float*)(F.lds);
    LAS int* ce = (LAS int*)(F.lds + 32768);
    const float* wr = (const float*)(F.ws + WS_WR) + (size_t)j * NE * D; const bf16* h = (const bf16*)(F.ws + WS_HB);
    int* tok_e = (int*)(F.ws + WS_TOKE); float* tok_w = (float*)(F.ws + WS_TOKW); int* rank = (int*)(F.ws + WS_RANK); float* rstd = (float*)(F.ws + WS_RSTD); int* bcnt = (int*)(F.ws + WS_BCNT);
    { float tmp[16];
#pragma unroll
      for (int i = 0; i < 16; ++i) tmp[i] = wr[F.tid + i * NWAVES * 64];
#pragma unroll
      for (int i = 0; i < 16; ++i) wrl[F.tid + i * NWAVES * 64] = tmp[i]; }
    __syncthreads();
    for (int tb = F.bx; tb < M / 64; tb += F.G) {
        f32x4 vn[4];
        { const bf16* hr0 = h + (size_t)(tb * 64 + F.wave * 8) * D + 4 * F.lane;
#pragma unroll
          for (int q = 0; q < 4; ++q) vn[q] = ldh4(hr0 + 256 * q); }
#pragma unroll
        for (int r = 0; r < 8; ++r) { const int t = tb * 64 + F.wave * 8 + r; f32x4 v[4]; float s = 0.f; float lg[NE];
#pragma unroll
            for (int q = 0; q < 4; ++q) v[q] = vn[q];
            if (r < 7) { const bf16* hr1 = h + (size_t)(t + 1) * D + 4 * F.lane;
#pragma unroll
                for (int q = 0; q < 4; ++q) vn[q] = ldh4(hr1 + 256 * q); }
#pragma unroll
            for (int q = 0; q < 4; ++q) s += (v[q][0] * v[q][0] + v[q][1] * v[q][1]) + (v[q][2] * v[q][2] + v[q][3] * v[q][3]);
#pragma unroll
            for (int e = 0; e < NE; ++e) { float a = 0.f;
#pragma unroll
                for (int q = 0; q < 4; ++q) { const f32x4 w = *(const LAS f32x4*)(wrl + e * D + 256 * q + 4 * F.lane); a += (v[q][0] * w[0] + v[q][1] * w[1]) + (v[q][2] * w[2] + v[q][3] * w[3]); }
                lg[e] = wave_sum(a); }
            s = wave_sum(s); const float rs = rsqrtf(s * (1.0f / D) + pg8::RMS_EPS);
            if (F.lane == 0) {
#pragma unroll
                for (int e = 0; e < NE; ++e) lg[e] *= rs;
                float l0 = lg[0]; int i0 = 0;
#pragma unroll
                for (int e = 1; e < NE; ++e) if (lg[e] > l0) { l0 = lg[e]; i0 = e; }
                float l1 = -3.0e38f; int i1 = 0;
#pragma unroll
                for (int e = 0; e < NE; ++e) if (e != i0 && lg[e] > l1) { l1 = lg[e]; i1 = e; }
                const float e1 = __expf(l1 - l0); const float w0 = 1.f / (1.f + e1);
                tok_e[t * 2] = i0; tok_e[t * 2 + 1] = i1; tok_w[t * 2] = w0; tok_w[t * 2 + 1] = e1 * w0; rstd[t] = rs;
                ce[(F.wave * 8 + r) * 2] = i0; ce[(F.wave * 8 + r) * 2 + 1] = i1; }
        }
        __syncthreads();
        { LAS int* wcnt = ce + 128;
          int e = -1, rk = 0;
          if (F.wave < 2) { e = ce[F.tid];
#pragma unroll
              for (int ee = 0; ee < NE; ++ee) { const unsigned long long mk = __ballot(e == ee); if (e == ee) rk = __popcll(mk & ((1ull << F.lane) - 1ull)); if (F.lane == 0) wcnt[F.wave * 8 + ee] = __popcll(mk); } }
          __syncthreads();
          if (F.wave < 2) { if (F.wave == 1) rk += wcnt[e]; rank[(tb * 64) * 2 + F.tid] = rk; }
          if (F.tid < NE) bcnt[tb * 8 + F.tid] = wcnt[F.tid] + wcnt[8 + F.tid];
          __syncthreads(); }
    }
}
__device__ __forceinline__ void moe_route_b(Frame& F, bool f8) {
    asm volatile("; RB_BEGIN" ::: "memory");
    LAS int* tot = (LAS int*)(F.lds); LAS int* offs = tot + 8; LAS int* base = tot + 16;
    const bf16* h = (const bf16*)(F.ws + WS_HB); const int* tok_e = (const int*)(F.ws + WS_TOKE); const int* rank = (const int*)(F.ws + WS_RANK); const float* rstd = (const float*)(F.ws + WS_RSTD);
    const int* bcnt = (const int*)(F.ws + WS_BCNT); int* slot_of = (int*)(F.ws + WS_SLOT); bf16* Xg = (bf16*)(F.ws + WS_XG); int* meta = (int*)(F.ws + WS_META);
    for (int tb = F.bx; tb < M / 64; tb += F.G) {
        LAS int* part = tot + 32;
        if (F.tid < 256) { const int4 c0 = *(const int4*)(bcnt + F.tid * 8), c1 = *(const int4*)(bcnt + F.tid * 8 + 4); const int cc[8] = {c0.x, c0.y, c0.z, c0.w, c1.x, c1.y, c1.z, c1.w}; const bool lower = F.tid < tb;
#pragma unroll
            for (int e = 0; e < NE; ++e) { const float st = wave_sum((float)cc[e]), so = wave_sum(lower ? (float)cc[e] : 0.f);
                if (F.lane == 0) { part[F.wave * 16 + e] = (int)st; part[F.wave * 16 + 8 + e] = (int)so; } } }
        __syncthreads();
        if (F.tid < 16) tot[F.tid] = part[F.tid] + part[16 + F.tid] + part[32 + F.tid] + part[48 + F.tid];
        __syncthreads();
        if (F.tid == 0) { int s = 0; for (int e = 0; e < NE; ++e) { base[e] = s; s += ((tot[e] + 255) / 256) * 256; }
            if (tb == 0) { int tp = 0; for (int e = 0; e < NE; ++e) { meta[e] = tp; tp += (tot[e] + 255) / 256; } meta[8] = tp; for (int e = 0; e < NE; ++e) meta[16 + e] = tot[e]; } }
        __syncthreads();
        f32x4 vn[4]; int me0, me1, mr0, mr1; float mrs;
        { const int t0 = tb * 64 + F.wave * 8; const bf16* hr0 = h + (size_t)t0 * D + 4 * F.lane;
#pragma unroll
          for (int q = 0; q < 4; ++q) vn[q] = ldh4(hr0 + 256 * q);
          me0 = tok_e[t0 * 2]; me1 = tok_e[t0 * 2 + 1]; mr0 = rank[t0 * 2]; mr1 = rank[t0 * 2 + 1]; mrs = rstd[t0]; }
#pragma unroll
        for (int r = 0; r < 8; ++r) { const int t = tb * 64 + F.wave * 8 + r; const float rs = mrs; const int e0 = me0, e1 = me1, k0 = mr0, k1 = mr1; f32x4 v[4];
#pragma unroll
            for (int q = 0; q < 4; ++q) v[q] = vn[q];
            if (r < 7) { const bf16* hr1 = h + (size_t)(t + 1) * D + 4 * F.lane;
#pragma unroll
                for (int q = 0; q < 4; ++q) vn[q] = ldh4(hr1 + 256 * q);
                me0 = tok_e[(t + 1) * 2]; me1 = tok_e[(t + 1) * 2 + 1]; mr0 = rank[(t + 1) * 2]; mr1 = rank[(t + 1) * 2 + 1]; mrs = rstd[t + 1]; }
            const int s0 = base[e0] + offs[e0] + k0, s1 = base[e1] + offs[e1] + k1;
            if (F.lane == 0) { slot_of[t * 2] = s0; slot_of[t * 2 + 1] = s1; }
            if (f8) { unsigned* o0 = (unsigned*)((unsigned char*)Xg + (size_t)s0 * D) + F.lane; unsigned* o1 = (unsigned*)((unsigned char*)Xg + (size_t)s1 * D) + F.lane;
#pragma unroll
                for (int q = 0; q < 4; ++q) { const f32x4 x = v[q] * (rs * F8_SX); const unsigned w = pg8::pack4_fp8(x[0], x[1], x[2], x[3]); o0[64 * q] = w; o1[64 * q] = w; }
                continue; }
            unsigned long long* o0 = (unsigned long long*)(Xg + (size_t)s0 * D) + F.lane; unsigned long long* o1 = (unsigned long long*)(Xg + (size_t)s1 * D) + F.lane;
#pragma unroll
            for (int q = 0; q < 4; ++q) { const f32x4 x = v[q] * rs; const unsigned long long w = (unsigned long long)pg8::cvt_pk_bf16(x[0], x[1]) | ((unsigned long long)pg8::cvt_pk_bf16(x[2], x[3]) << 32); o0[64 * q] = w; o1[64 * q] = w; } }
        if (tb < NE) { const int e = tb, lo = base[e] + tot[e], hi = base[e] + ((tot[e] + 255) / 256) * 256;
            for (int rr = lo + F.wave; rr < hi; rr += NWAVES) {
                if (f8) { unsigned* o = (unsigned*)((unsigned char*)Xg + (size_t)rr * D) + F.lane;
#pragma unroll
                    for (int q = 0; q < 4; ++q) o[64 * q] = 0u; }
                else { unsigned long long* o = (unsigned long long*)(Xg + (size_t)rr * D) + F.lane;
#pragma unroll
                    for (int q = 0; q < 4; ++q) o[64 * q] = 0ull; } } }
        __syncthreads();
    }
}
struct CmbTok { unsigned long long hv[4]; unsigned long long a[4], b[4]; f32x4 xa[4], xb[4]; float w0, w1; };
__device__ __forceinline__ f32x4 bf4(unsigned long long a) { f32x4 r; r[0] = __uint_as_float((unsigned)a << 16); r[1] = __uint_as_float((unsigned)a & 0xffff0000u); r[2] = __uint_as_float((unsigned)(a >> 32) << 16); r[3] = __uint_as_float((unsigned)(a >> 32) & 0xffff0000u); return r; }
__device__ __forceinline__ void cmb_load(CmbTok& T, const bf16* h, const bf16* Y, const bf16* YP, const LAS int* tab, const int* slot_of, const float* tok_w, int t, int lane, int np) {
    const int s0 = slot_of[t * 2], s1 = slot_of[t * 2 + 1]; T.w0 = tok_w[t * 2]; T.w1 = tok_w[t * 2 + 1];
    const unsigned long long* hr = (const unsigned long long*)(h + (size_t)t * D) + lane; const unsigned long long* y0 = (const unsigned long long*)(Y + (size_t)s0 * D) + lane; const unsigned long long* y1 = (const unsigned long long*)(Y + (size_t)s1 * D) + lane;
#pragma unroll
    for (int q = 0; q < 4; ++q) { T.hv[q] = hr[64 * q]; T.a[q] = __builtin_nontemporal_load(y0 + 64 * q); T.b[q] = __builtin_nontemporal_load(y1 + 64 * q);     T.xa[q] = (f32x4){0.f, 0.f, 0.f, 0.f}; T.xb[q] = (f32x4){0.f, 0.f, 0.f, 0.f}; }
#pragma unroll
    for (int q = 0; q < 4; ++q) { const int i0 = tab[(s0 >> 8) * 4 + q], i1 = tab[(s1 >> 8) * 4 + q];
        if (i0) { const unsigned long long* p = (const unsigned long long*)(YP + (size_t)(i0 - 1) * np * 65536 + (size_t)(s0 & 255) * 256) + lane; T.xa[q] = bf4(__builtin_nontemporal_load(p)); for (int r = 1; r < np; ++r) T.xa[q] += bf4(__builtin_nontemporal_load(p + (size_t)r * 16384)); }
        if (i1) { const unsigned long long* p = (const unsigned long long*)(YP + (size_t)(i1 - 1) * np * 65536 + (size_t)(s1 & 255) * 256) + lane; T.xb[q] = bf4(__builtin_nontemporal_load(p)); for (int r = 1; r < np; ++r) T.xb[q] += bf4(__builtin_nontemporal_load(p + (size_t)r * 16384)); } }
}
__device__ __forceinline__ void moe_combine(Frame& F, float* ssq_out, bool f8) {
    asm volatile("; CMB_BEGIN" ::: "memory");
    bf16* hb = (bf16*)(F.ws + WS_HB); const bf16* h = hb; const bf16* Y = (const bf16*)(F.ws + WS_XG); const bf16* YP = (const bf16*)(F.ws + WS_YP); const int* slot_of = (const int*)(F.ws + WS_SLOT); const float* tok_w = (const float*)(F.ws + WS_TOKW);
    LAS int* tab = (LAS int*)(F.lds);
    int np;
    { const int* meta = (const int*)(F.ws + WS_META);
      pg8::MoeOrder S; S.nN = D / 256; S.G = F.G; S.c = 0;
#pragma unroll
      for (int e = 0; e < 9; ++e) S.tpre[e] = __builtin_amdgcn_readfirstlane(meta[e]);
      S.nM = S.tpre[8]; S.nwg = S.nM * S.nN; S.nlim = S.nwg;
      int L0, nleft; pg8::moe_split_plan(S.nwg, F.G, L0, nleft);
      np = f8 ? (nleft * 7 <= (int)F.G ? 6 : 1) : 3;
      for (int i = F.tid; i < 137 * 4; i += NWAVES * 64) tab[i] = 0;
      __syncthreads();
      if (F.tid < nleft) { pg8::Unit u; S.map(L0 + F.tid, u); tab[u.pm * 4 + u.pn] = F.tid + 1; }
      __syncthreads(); }
    for (int i = F.gw * 64 + F.lane; i < 15 * M / 4; i += F.NGW * 64) ((f32x4*)(ssq_out + M))[i] = (f32x4){0.f, 0.f, 0.f, 0.f};
    CmbTok cur, nxt; int t = F.gw;
    if (t < M) cmb_load(cur, h, Y, YP, tab, slot_of, tok_w, t, F.lane, np);
    for (; t < M; t += F.NGW) { const int tn = t + F.NGW;
        if (tn < M) cmb_load(nxt, h, Y, YP, tab, slot_of, tok_w, tn, F.lane, np);
        unsigned long long* o8 = (unsigned long long*)(hb + (size_t)t * D) + F.lane; float s = 0.f; const float w0 = cur.w0, w1 = cur.w1;
#pragma unroll
        for (int q = 0; q < 4; ++q) { const f32x4 v = bf4(cur.hv[q]) + w0 * (bf4(cur.a[q]) + cur.xa[q]) + w1 * (bf4(cur.b[q]) + cur.xb[q]);
            s += (v[0] * v[0] + v[1] * v[1]) + (v[2] * v[2] + v[3] * v[3]);
            o8[64 * q] = (unsigned long long)pg8::cvt_pk_bf16(v[0], v[1]) | ((unsigned long long)pg8::cvt_pk_bf16(v[2], v[3]) << 32); }
        s = wave_sum(s);
        if (F.lane == 0) ssq_out[t] = s;
        cur = nxt; }
}
__device__ __forceinline__ void final_norm(Frame& F) {
    const bf16* h = (const bf16*)(F.ws + WS_HB); const f32x4* g = (const f32x4*)KIN(F, 20) + F.lane;
    f32x4 gq[4];
#pragma unroll
    for (int q = 0; q < 4; ++q) gq[q] = g[64 * q];
    for (int t = F.gw; t < M; t += 2 * F.NGW) { const int t2 = t + F.NGW; const bool two = t2 < M;
        const bf16* hr = h + (size_t)t * D + 4 * F.lane; const bf16* hr2 = h + (size_t)(two ? t2 : t) * D + 4 * F.lane; f32x4 v[4], w[4]; float s = 0.f, s2 = 0.f;
#pragma unroll
        for (int q = 0; q < 4; ++q) { v[q] = ldh4nt(hr + 256 * q); w[q] = ldh4nt(hr2 + 256 * q); }
#pragma unroll
        for (int q = 0; q < 4; ++q) { s += (v[q][0] * v[q][0] + v[q][1] * v[q][1]) + (v[q][2] * v[q][2] + v[q][3] * v[q][3]); s2 += (w[q][0] * w[q][0] + w[q][1] * w[q][1]) + (w[q][2] * w[q][2] + w[q][3] * w[q][3]); }
        s = wave_sum(s); s2 = wave_sum(s2); const float rs = rsqrtf(s * (1.0f / D) + pg8::RMS_EPS), rs2 = rsqrtf(s2 * (1.0f / D) + pg8::RMS_EPS);
        f32x4* o = (f32x4*)(F.out + (size_t)t * D) + F.lane; f32x4* o2 = (f32x4*)(F.out + (size_t)t2 * D) + F.lane;
#pragma unroll
        for (int q = 0; q < 4; ++q) __builtin_nontemporal_store(v[q] * rs * gq[q], o + 64 * q);
        if (two) {
#pragma unroll
            for (int q = 0; q < 4; ++q) __builtin_nontemporal_store(w[q] * rs2 * gq[q], o2 + 64 * q); } }
}
typedef float f32x16_t __attribute__((ext_vector_type(16)));
constexpr float LOG2E = 1.4426950408889634f;
__device__ __forceinline__ float exp_f(float x) { return __builtin_amdgcn_exp2f(x * LOG2E); }
__device__ __forceinline__ float bfbits2f(unsigned short u) { return __uint_as_float((unsigned)u << 16); }
__device__ __forceinline__ int crow_(int r, int hi) { return (r & 3) + 8 * (r >> 2) + 4 * hi; }
__device__ __forceinline__ bf16x8 mk8(unsigned a, unsigned b, unsigned c, unsigned d) { v4u t; t.x = a; t.y = b; t.z = c; t.w = d; return __builtin_bit_cast(bf16x8, t); }
__device__ __forceinline__ void stage_tile64(const bf16* src, LAS unsigned char* dst, int lane) {
    v4u x[8]; const bf16* p = src + (size_t)(lane >> 3) * 512 + (lane & 7) * 8;
#pragma unroll
    for (int i = 0; i < 8; ++i) { x[i] = __builtin_nontemporal_load((const v4u*)p); p += 8 * 512; asm volatile("" : "+v"(p)); }
#pragma unroll
    for (int i = 0; i < 8; ++i) *(LAS v4u*)(dst + ((lane >> 3) + 8 * i) * 128 + (lane & 7) * 16) = x[i];
}
__device__ __forceinline__ void stage_tile64x2(const bf16* srcA, LAS unsigned char* dstA, const bf16* srcB, LAS unsigned char* dstB, int lane) {
    v4u x[8], y[8]; const bf16* p = srcA + (size_t)(lane >> 3) * 512 + (lane & 7) * 8; const bf16* q = srcB + (size_t)(lane >> 3) * 512 + (lane & 7) * 8;
#pragma unroll
    for (int i = 0; i < 8; ++i) { x[i] = *(const v4u*)p; y[i] = *(const v4u*)q; p += 8 * 512; q += 8 * 512; asm volatile("" : "+v"(p), "+v"(q)); }
#pragma unroll
    for (int i = 0; i < 8; ++i) { *(LAS v4u*)(dstA + ((lane >> 3) + 8 * i) * 128 + (lane & 7) * 16) = x[i]; *(LAS v4u*)(dstB + ((lane >> 3) + 8 * i) * 128 + (lane & 7) * 16) = y[i]; }
}
__device__ __forceinline__ float rdlane_f(float v, int l) { return __builtin_bit_cast(float, __builtin_amdgcn_readlane(__builtin_bit_cast(int, v), l)); }
__device__ __forceinline__ float log2_f(float x) { return __builtin_amdgcn_logf(x); }
__device__ __forceinline__ void hgrn_pass1(Frame& F, int layer) {
    const bf16* zb = (const bf16*)(F.ws + WS_ZB); const bf16* HF = zb + 4 * ZARR; const bf16* HI = zb + 5 * ZARR;
    const float* lb = (const float*)(F.ws + WS_LB) + layer * 512; float* Lt = (float*)(F.ws + WS_HL); float* gd = (float*)(F.ws + WS_HG_);
    LAS unsigned char* wl = F.lds + RING_OFF + F.wave * 16384;
    for (int item = F.gw; item < 2048; item += F.NGW) {
        int lane = F.lane; asm volatile("" : "+v"(lane));
        const int dl = lane & 31, tq = lane >> 5;
        const int bh = item >> 5, c = item & 31, b = bh >> 3, h = bh & 7; const size_t row0 = (size_t)b * SEQ + c * 64;
        const float lbv0 = lb[h * 64 + dl], lbv1 = lb[h * 64 + dl + 32];
        stage_tile64x2(HI + row0 * 512 + h * 64, wl, HF + row0 * 512 + h * 64, wl + 8192, lane);
        LDS_WAIT();
        bf16x8 Vop[2][4];
#pragma unroll
        for (int nt = 0; nt < 2; ++nt)
#pragma unroll
            for (int s = 0; s < 4; ++s) { unsigned w[4];
#pragma unroll
                for (int jj = 0; jj < 4; ++jj) { const unsigned lo = *(const LAS unsigned short*)(wl + (32 * tq + 8 * s + 2 * jj) * 128 + (dl + 32 * nt) * 2), hi = *(const LAS unsigned short*)(wl + (32 * tq + 8 * s + 2 * jj + 1) * 128 + (dl + 32 * nt) * 2); w[jj] = lo | (hi << 16); }
                Vop[nt][s] = mk8(w[0], w[1], w[2], w[3]); }
        f32x16_t acc[2][2];
        { float z0 = 0.f; asm volatile("" : "+v"(z0));
#pragma unroll
          for (int r = 0; r < 16; ++r) { acc[0][0][r] = z0; acc[0][1][r] = z0; acc[1][0][r] = z0; acc[1][1][r] = z0; } }
#pragma unroll
        for (int dh = 0; dh < 2; ++dh) { const int d = dl + 32 * dh; const float lbv = dh ? lbv1 : lbv0, oml = 1.f - lbv;
            float bl[32], kk[32];
#pragma unroll
            for (int i = 0; i < 32; ++i) { const float z = bfbits2f(*(const LAS unsigned short*)(wl + 8192 + (32 * tq + i) * 128 + d * 2));
                const float sn = __builtin_amdgcn_rcpf(1.f + __builtin_amdgcn_exp2f(z * LOG2E)); const float k = oml * sn; kk[i] = k; bl[i] = log2_f(1.f - k); }
#pragma unroll
            for (int i = 1; i < 32; ++i) bl[i] += bl[i - 1];
            const float tot = bl[31];
            const auto rr = __builtin_amdgcn_permlane32_swap(__float_as_uint(tot), __float_as_uint(tot), false, false);
            const float tot_lo = tq ? __uint_as_float(rr[0]) : tot, tot_hi = tq ? tot : __uint_as_float(rr[1]);
            const float bend = tot_lo + tot_hi, off = tq ? tot_lo : 0.f;
            if (tq == 0) gd[(size_t)item * 64 + d] = __builtin_amdgcn_exp2f(bend);
            bf16x8 Aop[4];
#pragma unroll
            for (int s = 0; s < 4; ++s) { unsigned w[4];
#pragma unroll
                for (int jj = 0; jj < 4; ++jj) { const int i0 = 8 * s + 2 * jj; w[jj] = pg8::cvt_pk_bf16(kk[i0] * __builtin_amdgcn_exp2f(bend - (bl[i0] + off)), kk[i0 + 1] * __builtin_amdgcn_exp2f(bend - (bl[i0 + 1] + off))); }
                Aop[s] = mk8(w[0], w[1], w[2], w[3]); }
#pragma unroll
            for (int nt = 0; nt < 2; ++nt)
#pragma unroll
                for (int s = 0; s < 4; ++s) acc[dh][nt] = __builtin_amdgcn_mfma_f32_32x32x16_bf16(Aop[s], Vop[nt][s], acc[dh][nt], 0, 0, 0);
        }
        float* Lo = Lt + (size_t)item * 4096;
#pragma unroll
        for (int dh = 0; dh < 2; ++dh)
#pragma unroll
            for (int nt = 0; nt < 2; ++nt)
#pragma unroll
                for (int g = 0; g < 4; ++g) { f32x4 val; val[0] = acc[dh][nt][4 * g]; val[1] = acc[dh][nt][4 * g + 1]; val[2] = acc[dh][nt][4 * g + 2]; val[3] = acc[dh][nt][4 * g + 3];
                    if (MK_LT16) { pg8::u32x2 w; w.x = pg8::cvt_pk_bf16(val[0], val[1]); w.y = pg8::cvt_pk_bf16(val[2], val[3]); *(pg8::u32x2*)((bf16*)Lt + (size_t)item * 4096 + (32 * nt + dl) * 64 + 32 * dh + 8 * g + 4 * tq) = w; }
                    else *(f32x4*)(Lo + (32 * nt + dl) * 64 + 32 * dh + 8 * g + 4 * tq) = val; }
        LDS_WAIT(); asm volatile("" ::: "memory");
    }
    asm volatile("; P3_END" ::: "memory");
}
__device__ __forceinline__ void hgrn_scan(Frame& F) {
    const float* Lt = (const float*)(F.ws + WS_HL); const float* gd = (const float*)(F.ws + WS_HG_); bf16* St = (bf16*)(F.ws + WS_HS);
    if (F.tid >= 256) return;
    for (int task = F.bx * 256 + F.tid; task < 65536; task += F.G * 256) {
        const int bh = task >> 10, v = (task >> 4) & 63, d0 = (task & 15) * 4;
        f32x4 cur = (f32x4){0.f, 0.f, 0.f, 0.f};
#pragma unroll 16
        for (int c = 0; c < 32; ++c) { const size_t item = (size_t)bh * 32 + c;
            f32x4 L; if (MK_LT16) { const pg8::u32x2 w = __builtin_nontemporal_load((const pg8::u32x2*)((const bf16*)Lt + item * 4096 + v * 64 + d0)); L[0] = __uint_as_float(w.x << 16); L[1] = __uint_as_float(w.x & 0xffff0000u); L[2] = __uint_as_float(w.y << 16); L[3] = __uint_as_float(w.y & 0xffff0000u); }
            else L = __builtin_nontemporal_load((const f32x4*)(Lt + item * 4096 + v * 64 + d0));
            const f32x4 g = *(const f32x4*)(gd + item * 64 + d0);
            pg8::u32x2 w; w.x = pg8::cvt_pk_bf16(cur[0], cur[1]); w.y = pg8::cvt_pk_bf16(cur[2], cur[3]); *(pg8::u32x2*)(St + item * 4096 + v * 64 + d0) = w;
            cur = g * cur + L; }
    }
}
__device__ __forceinline__ void hgrn_pass3(Frame& F, int layer) {
    asm volatile("; P3_BEGIN" ::: "memory");
    const bf16* zb = (const bf16*)(F.ws + WS_ZB); const bf16* HQ = zb + 3 * ZARR; const bf16* HF = zb + 4 * ZARR; const bf16* HI = zb + 5 * ZARR; const bf16* HG = zb + 6 * ZARR;
    const float* lb = (const float*)(F.ws + WS_LB) + layer * 512; const bf16* St = (const bf16*)(F.ws + WS_HS); const float* gain = KIN(F, 6) + layer * 512; bf16* mix = (bf16*)(F.ws + WS_MIX);
    LAS unsigned char* wl = F.lds + RING_OFF + F.wave * 16384;
    for (int item = F.gw; item < 2048; item += F.NGW) {
        int lane = F.lane; asm volatile("" : "+v"(lane));
        const int vl = lane & 31, hi = lane >> 5;
        const int bh = item >> 5, c = item & 31, b = bh >> 3, h = bh & 7; const size_t row0 = (size_t)b * SEQ + c * 64; const size_t row = row0 + lane;
        const float lbl = lb[h * 64 + lane], gnl = gain[h * 64 + lane];
        stage_tile64(HI + row0 * 512 + h * 64, wl, lane);
        f32x16_t out[2][2], sc[3];
        { float z0 = 0.f; asm volatile("" : "+v"(z0));
#pragma unroll
          for (int r = 0; r < 16; ++r) { out[0][0][r] = z0; out[0][1][r] = z0; out[1][0][r] = z0; out[1][1][r] = z0; sc[0][r] = z0; sc[1][r] = z0; sc[2][r] = z0; } }
#pragma unroll
        for (int s = 0; s < 4; ++s) {
            const v4u zf0 = *(const v4u*)(HF + row * 512 + h * 64 + 16 * s), zf1 = *(const v4u*)(HF + row * 512 + h * 64 + 16 * s + 8);
            const v4u q0 = *(const v4u*)(HQ + row * 512 + h * 64 + 16 * s), q1 = *(const v4u*)(HQ + row * 512 + h * 64 + 16 * s + 8);
            const unsigned zw[8] = {zf0.x, zf0.y, zf0.z, zf0.w, zf1.x, zf1.y, zf1.z, zf1.w}; const unsigned qw[8] = {q0.x, q0.y, q0.z, q0.w, q1.x, q1.y, q1.z, q1.w};
            float qd[16], qm[16], km[16];
#pragma unroll
            for (int i = 0; i < 16; ++i) { const float z = (i & 1) ? __uint_as_float(zw[i >> 1] & 0xffff0000u) : __uint_as_float(zw[i >> 1] << 16);
                const float q = (i & 1) ? __uint_as_float(qw[i >> 1] & 0xffff0000u) : __uint_as_float(qw[i >> 1] << 16);
                const float lbv = rdlane_f(lbl, 16 * s + i); const float sn = __builtin_amdgcn_rcpf(1.f + __builtin_amdgcn_exp2f(z * LOG2E)); const float k = (1.f - lbv) * sn;
                const float bb = wave_incl_scan(log2_f(1.f - k));
                const float bmid = __builtin_bit_cast(float, __builtin_amdgcn_readlane(__builtin_bit_cast(int, bb), 31));
                qd[i] = q * __builtin_amdgcn_exp2f(bb); qm[i] = q * __builtin_amdgcn_exp2f(fminf(bb - bmid, 115.f)); km[i] = k * __builtin_amdgcn_exp2f(fminf(bmid - bb, 115.f)); }
            unsigned QdL[4], QdH[4], QmL[4], QmH[4], KmL[4], KmH[4];
#pragma unroll
            for (int jj = 0; jj < 4; ++jj) { QdL[jj] = pg8::cvt_pk_bf16(qd[2 * jj], qd[2 * jj + 1]); QdH[jj] = pg8::cvt_pk_bf16(qd[8 + 2 * jj], qd[9 + 2 * jj]);
                QmL[jj] = pg8::cvt_pk_bf16(qm[2 * jj], qm[2 * jj + 1]); QmH[jj] = pg8::cvt_pk_bf16(qm[8 + 2 * jj], qm[9 + 2 * jj]);
                KmL[jj] = pg8::cvt_pk_bf16(km[2 * jj], km[2 * jj + 1]); KmH[jj] = pg8::cvt_pk_bf16(km[8 + 2 * jj], km[9 + 2 * jj]); }
            unsigned Qd0[4], Qd1[4], Qm0[4], Qm1[4], Km0[4], Km1[4];
#pragma unroll
            for (int jj = 0; jj < 4; ++jj) { auto r1 = __builtin_amdgcn_permlane32_swap(QdL[jj], QdH[jj], false, false); Qd0[jj] = r1[0]; Qd1[jj] = r1[1];
                auto r2 = __builtin_amdgcn_permlane32_swap(QmL[jj], QmH[jj], false, false); Qm0[jj] = r2[0]; Qm1[jj] = r2[1];
                auto r3 = __builtin_amdgcn_permlane32_swap(KmL[jj], KmH[jj], false, false); Km0[jj] = r3[0]; Km1[jj] = r3[1]; }
            const bf16x8 aQd0 = mk8(Qd0[0], Qd0[1], Qd0[2], Qd0[3]), aQd1 = mk8(Qd1[0], Qd1[1], Qd1[2], Qd1[3]), aQm0 = mk8(Qm0[0], Qm0[1], Qm0[2], Qm0[3]), aQm1 = mk8(Qm1[0], Qm1[1], Qm1[2], Qm1[3]),
                         aKm0 = mk8(Km0[0], Km0[1], Km0[2], Km0[3]), aKm1 = mk8(Km1[0], Km1[1], Km1[2], Km1[3]);
            const bf16x8 So0 = *(const bf16x8*)(St + (size_t)item * 4096 + (vl) * 64 + 16 * s + 8 * hi), So1 = *(const bf16x8*)(St + (size_t)item * 4096 + (vl + 32) * 64 + 16 * s + 8 * hi);
            out[0][0] = __builtin_amdgcn_mfma_f32_32x32x16_bf16(aQd0, So0, out[0][0], 0, 0, 0); out[0][1] = __builtin_amdgcn_mfma_f32_32x32x16_bf16(aQd0, So1, out[0][1], 0, 0, 0);
            out[1][0] = __builtin_amdgcn_mfma_f32_32x32x16_bf16(aQd1, So0, out[1][0], 0, 0, 0); out[1][1] = __builtin_amdgcn_mfma_f32_32x32x16_bf16(aQd1, So1, out[1][1], 0, 0, 0);
            sc[0] = __builtin_amdgcn_mfma_f32_32x32x16_bf16(aKm0, aQm0, sc[0], 0, 0, 0); sc[1] = __builtin_amdgcn_mfma_f32_32x32x16_bf16(aKm0, aQm1, sc[1], 0, 0, 0);
            sc[2] = __builtin_amdgcn_mfma_f32_32x32x16_bf16(aKm1, aQm1, sc[2], 0, 0, 0);
        }
        { int vlm = vl, him = hi; asm volatile("" : "+v"(vlm), "+v"(him));
          _Pragma("unroll") for (int r = 0; r < 16; ++r) { const bool keep = crow_(r, him) <= vlm; sc[0][r] = keep ? sc[0][r] : 0.f; sc[2][r] = keep ? sc[2][r] : 0.f; } }
        LDS_WAIT();
#pragma unroll
        for (int kk = 0; kk < 2; ++kk) {
            bf16x8 Vo[2][2];
#pragma unroll
            for (int ms = 0; ms < 2; ++ms)
#pragma unroll
                for (int nt = 0; nt < 2; ++nt) { unsigned w[4];
#pragma unroll
                    for (int jj = 0; jj < 4; ++jj) { const int j0 = 2 * jj; const int s0 = 32 * ms + 16 * kk + 4 * hi + (j0 & 3) + 8 * (j0 >> 2);
                        const unsigned lo = *(const LAS unsigned short*)(wl + s0 * 128 + (vl + 32 * nt) * 2), hh = *(const LAS unsigned short*)(wl + (s0 + 1) * 128 + (vl + 32 * nt) * 2); w[jj] = lo | (hh << 16); }
                    Vo[ms][nt] = mk8(w[0], w[1], w[2], w[3]); }
            bf16x8 P[3];
#pragma unroll
            for (int q = 0; q < 3; ++q) P[q] = mk8(pg8::cvt_pk_bf16(sc[q][8 * kk], sc[q][8 * kk + 1]), pg8::cvt_pk_bf16(sc[q][8 * kk + 2], sc[q][8 * kk + 3]), pg8::cvt_pk_bf16(sc[q][8 * kk + 4], sc[q][8 * kk + 5]), pg8::cvt_pk_bf16(sc[q][8 * kk + 6], sc[q][8 * kk + 7]));
#pragma unroll
            for (int nt = 0; nt < 2; ++nt) {
                out[0][nt] = __builtin_amdgcn_mfma_f32_32x32x16_bf16(P[0], Vo[0][nt], out[0][nt], 0, 0, 0);
                out[1][nt] = __builtin_amdgcn_mfma_f32_32x32x16_bf16(P[1], Vo[0][nt], out[1][nt], 0, 0, 0);
                out[1][nt] = __builtin_amdgcn_mfma_f32_32x32x16_bf16(P[2], Vo[1][nt], out[1][nt], 0, 0, 0); }
        }
        LDS_WAIT(); asm volatile("" ::: "memory");
        v4u gq[8];
#pragma unroll
        for (int ch = 0; ch < 8; ++ch) gq[ch] = *(const v4u*)(HG + row * 512 + h * 64 + ch * 8);
#pragma unroll
        for (int mt = 0; mt < 2; ++mt)
#pragma unroll
            for (int nt = 0; nt < 2; ++nt)
#pragma unroll
                for (int r = 0; r < 16; ++r) *(LAS unsigned short*)(wl + (32 * mt + crow_(r, hi)) * 144 + (32 * nt + vl) * 2) = (unsigned short)(pg8::cvt_pk_bf16(out[mt][nt][r], 0.f) & 0xffffu);
        LDS_WAIT(); asm volatile("" ::: "memory");
        float vv[64]; float ss = 0.f;
#pragma unroll
        for (int ch = 0; ch < 8; ++ch) { const v4u x = *(const LAS v4u*)(wl + lane * 144 + ch * 16); const unsigned xw[4] = {x.x, x.y, x.z, x.w};
#pragma unroll
            for (int q = 0; q < 4; ++q) { const float a = __uint_as_float(xw[q] << 16), bq = __uint_as_float(xw[q] & 0xffff0000u); vv[ch * 8 + 2 * q] = a; vv[ch * 8 + 2 * q + 1] = bq; ss += a * a + bq * bq; } }
        const float rs = rsqrtf(ss * (1.0f / 64.0f) + 1e-6f);
#pragma unroll
        for (int ch = 0; ch < 8; ++ch) { const unsigned gw[4] = {gq[ch].x, gq[ch].y, gq[ch].z, gq[ch].w}; unsigned ow[4];
#pragma unroll
            for (int q = 0; q < 4; ++q) { const float g0 = __uint_as_float(gw[q] << 16), g1 = __uint_as_float(gw[q] & 0xffff0000u);
                ow[q] = pg8::cvt_pk_bf16(vv[ch * 8 + 2 * q] * rs * rdlane_f(gnl, ch * 8 + 2 * q) * pg8::silu_f(g0), vv[ch * 8 + 2 * q + 1] * rs * rdlane_f(gnl, ch * 8 + 2 * q + 1) * pg8::silu_f(g1)); }
            v4u o; o.x = ow[0]; o.y = ow[1]; o.z = ow[2]; o.w = ow[3]; *(v4u*)(mix + row * D + 512 + h * 64 + ch * 8) = o; }
        LDS_WAIT(); asm volatile("" ::: "memory");
    }
    asm volatile("; P3_END" ::: "memory");
}
#if MK_NAIVE_ATTN
__global__ void __launch_bounds__(256) k_fox_attn_n(const bf16* __restrict__ zb, const float* __restrict__ c, const float* __restrict__ gain, bf16* __restrict__ mix) {
    __shared__ float Ks[64][64]; __shared__ float Vs[64][64]; __shared__ float Cs[64];
    const int qb = blockIdx.x, bh = blockIdx.y, b = bh / NHEAD, h = bh % NHEAD, tid = threadIdx.x;
    const int qi = qb * 256 + tid; const size_t rowq = (size_t)(b * SEQ + qi);
    const bf16* Q = zb; const bf16* K = zb + ZARR; const bf16* V = zb + 2 * ZARR;
    float q[64], o[64];
#pragma unroll
    for (int d = 0; d < 64; ++d) { q[d] = pg8::bf2f(Q[rowq * 512 + h * HD + d]) * LN2; o[d] = 0.f; }
    const float cq = c[(size_t)bh * SEQ + qi]; float mx = -1e30f, l = 0.f;
    const int ntile = (qb * 256 + 256) / 64;
    for (int kt = 0; kt < ntile; ++kt) {
        __syncthreads();
        for (int e = tid; e < 64 * 64; e += 256) { const int r = e / 64, cc = e % 64; const size_t rk = (size_t)(b * SEQ + kt * 64 + r);
            Ks[r][cc] = pg8::bf2f(K[rk * 512 + h * HD + cc]); Vs[r][cc] = pg8::bf2f(V[rk * 512 + h * HD + cc]); }
        if (tid < 64) Cs[tid] = c[(size_t)bh * SEQ + kt * 64 + tid];
        __syncthreads();
        for (int j = 0; j < 64; ++j) {
            const int kj = kt * 64 + j; if (kj > qi) break;
            float s = 0.f;
#pragma unroll
            for (int d = 0; d < 64; ++d) s += q[d] * Ks[j][d];
            s += cq - Cs[j];
            if (s > mx) { const float f = __expf(mx - s); l *= f;
#pragma unroll
                for (int d = 0; d < 64; ++d) o[d] *= f;
                mx = s; }
            const float pw = __expf(s - mx); l += pw;
#pragma unroll
            for (int d = 0; d < 64; ++d) o[d] += pw * Vs[j][d];
        }
    }
    const float il = 1.f / l; float ss = 0.f;
#pragma unroll
    for (int d = 0; d < 64; ++d) { o[d] *= il; ss += o[d] * o[d]; }
    const float r = rsqrtf(ss / 64.f + 1e-6f);
#pragma unroll
    for (int d = 0; d < 64; d += 2) *(unsigned*)(mix + rowq * D + h * HD + d) = pg8::cvt_pk_bf16(o[d] * r * gain[h * HD + d], o[d + 1] * r * gain[h * HD + d + 1]);
}
#endif
#if MK_NAIVE_HGRN
__global__ void __launch_bounds__(64) k_hgrn_n(const bf16* __restrict__ zb, const float* __restrict__ lb, const float* __restrict__ gain, bf16* __restrict__ mix) {
    const int bh = blockIdx.x, b = bh / NHEAD, h = bh % NHEAD, v = threadIdx.x;
    const bf16* HQ = zb + 3 * ZARR; const bf16* HF = zb + 4 * ZARR; const bf16* HI = zb + 5 * ZARR; const bf16* HG = zb + 6 * ZARR;
    float S[64], lbv[64];
#pragma unroll
    for (int d = 0; d < 64; ++d) { S[d] = 0.f; lbv[d] = lb[h * HD + d]; }
    const float gn = gain[h * HD + v];
    for (int t = 0; t < SEQ; ++t) {
        const size_t row = (size_t)(b * SEQ + t); float o = 0.f; const float vi = pg8::bf2f(HI[row * 512 + h * HD + v]);
#pragma unroll
        for (int d = 0; d < 64; ++d) { const float f = lbv[d] + (1.f - lbv[d]) * pg8::sigm_f(pg8::bf2f(HF[row * 512 + h * HD + d])); S[d] = f * S[d] + (1.f - f) * vi; o += S[d] * pg8::bf2f(HQ[row * 512 + h * HD + d]); }
        const float ss = wave_sum(o * o); const float r = rsqrtf(ss / 64.f + 1e-6f); const float g = pg8::bf2f(HG[row * 512 + h * HD + v]);
        const float outv = o * r * gn * pg8::silu_f(g);
        mix[row * D + 512 + h * HD + v] = (bf16)(pg8::cvt_pk_bf16(outv, 0.f) & 0xffffu);
    }
}
#endif

__host__ __device__ constexpr int steps_per_layer(int i) { return (i & 1) ? 11 : 8; }
__host__ __device__ constexpr int total_steps() { return 1 + 8 + 11 + 8 + 11 + 1; }

__global__ void __launch_bounds__(NWAVES * 64, 2) mk_fwd(Args args) {
    extern __shared__ __attribute__((aligned(16))) unsigned char lds[];
    Frame F;
    F.lds = (LAS unsigned char*)lds; F.MISC = (volatile LAS unsigned*)(F.lds + MISC_OFF);
    F.tid = threadIdx.x; F.lane = F.tid & 63; F.wave = __builtin_amdgcn_readfirstlane(F.tid >> 6);
    F.G = gridDim.x; F.bx = blockIdx.x; F.gw = blockIdx.x * NWAVES + F.wave; F.NGW = F.G * NWAVES;
    F.ka = (KArgs*)__builtin_amdgcn_kernarg_segment_ptr(); F.out = args.out; F.ws = (GAS unsigned char*)args.ws;
    GAS unsigned char* ws = (GAS unsigned char*)args.ws;
    gu32* ctl = (gu32*)(ws + WS_CTL);
    for (int u = F.tid; u < (LDS_BYTES - LDSCTL_OFF) / 4; u += NWAVES * 64) ((LAS unsigned*)(F.lds + LDSCTL_OFF))[u] = 0u;
    __syncthreads();
    XcdBarrier bar = xcd_barrier_post((unsigned*)(ctl + CW_BAR) + args.li * XCD_BAR_WORDS, F.MISC + 8, F.wave);
    F.tid = 0; F.lane = 0; F.gw = 0;
    const int s_lo = args.s_lo, s_hi = args.s_hi;
    int step = 0;
#define RUN_STEP() (step >= s_lo && step < s_hi)
#define F8LAYER(l) (MK_FP8_LAST && ((l) == 3 || (MK_FP8_L1 && (l) == 1)))
#define PROBE_DUP(ids, ...) do { __VA_ARGS__; if constexpr (ids) { STEP_PRO(); __VA_ARGS__; } } while (0)
#define STEP_PRO() do { asm volatile("" : "+s"(F.wave)); F.lane = lane_id_volatile(); F.tid = F.wave * 64 + F.lane; F.bx = blockIdx.x; asm volatile("" : "+s"(F.bx));   F.gw = F.bx * NWAVES + F.wave; asm volatile("" : "+s"(ws), "+s"(F.G)); F.ws = ws; F.NGW = F.G * NWAVES; F.ka = (KArgs*)__builtin_amdgcn_kernarg_segment_ptr(); asm volatile("" : "+s"(F.ka)); } while (0)
#define END_STEP() do { if (RUN_STEP() && step + 1 < s_hi) { asm volatile("" : "+s"(bar.x)); \
        if constexpr (cv::QB > 0) xcd_barrier_idle(bar, F.wave, [&]() { constexpr int W0_ = 8 - cv::QB / 256;   \
            if (F.G == 256 && F.wave >= 2 && F.wave < 4 && step < PB_SHARES) pb_barrier_share(F, step, lane_id_volatile()); \
            if (F.G == 256 && F.wave >= W0_) { int lo_, hi_; cv::bar_range(step, lo_, hi_); const int it_ = lo_ + F.bx * (8 - W0_) + (F.wave - W0_); \
            if (it_ < hi_) conv_item(F, it_, (LAS float*)(F.lds + RING_OFF + F.wave * 16384), lane_id_volatile()); } });   \
        else xcd_barrier(bar, F.wave); \
        if constexpr (MK_PROBE == 11) { asm volatile("" : "+s"(bar.x)); xcd_barrier(bar, F.wave); } } ++step; } while (0)
static_assert(MK_ONE_LAUNCH || cv::QB == 0, "barrier-time conversion needs the one-launch step program");
#define hb ((bf16*)(ws + WS_HB))
#define h ((float*)(ws + WS_H))
#define ssq0 ((float*)(ws + WS_SSQ))
#define zb ((bf16*)(ws + WS_ZB))
#define mix ((bf16*)(ws + WS_MIX))
    int par = 0;
#define SSQ(pp) (ssq0 + (size_t)(pp) * M * 16)

    if (RUN_STEP()) { STEP_PRO(); PROBE_DUP(MK_PROBE == 1, p0_prologue(F)); }
    END_STEP();

    for (int layer = 0; layer < DEPTH; ++layer) {
        const int j = layer >> 1; const bool moe = (layer & 1) != 0;
        if (RUN_STEP()) { STEP_PRO();
            pg8::StaticOrder S; S.init(M, NIN, F.G, F.bx);
            if (F8IN(layer)) { pg8::Gemm g{(const bf16*)(ws + WS_H8), (const bf16*)(ws + WS_WIN) + (size_t)layer * NIN * D, M, NIN, D / 2, D / 2};
                pg8::EpiInT<-8> E{zb, ZARR, (float*)(ws + WS_FG), SSQ(par), C2};
                pg8::gemm_phase<pg8::EpiInT<-8>, pg8::StaticOrder, true, true, true>(F.lds + RING_OFF, g, S, E, F.tid); }
            else { pg8::Gemm g{hb, (const bf16*)(ws + WS_WIN) + (size_t)layer * NIN * D, M, NIN, D, D};
                pg8::EpiIn E{zb, ZARR, (float*)(ws + WS_FG), SSQ(par), C2};
                PROBE_DUP(MK_PROBE == 10, pg8::gemm_phase<pg8::EpiIn, pg8::StaticOrder, true, true>(F.lds + RING_OFF, g, S, E, F.tid)); }
            if (F.G == 256 && F.bx >= 192) { STEP_PRO(); const int lo = layer == 0 ? 0 : layer == 1 ? cv::D1A : layer == 2 ? cv::E3_LO : cv::E3_LO + cv::D3A, hi = layer == 0 ? cv::D1A : layer == 1 ? cv::D1B : layer == 2 ? cv::E3_LO + cv::D3A : cv::E3_LO + cv::D3B; conv_range(F, lo, hi, F.bx - 192, 64); }
        }
        END_STEP();
        if (RUN_STEP()) { STEP_PRO();
#if !MK_NAIVE_HGRN
            PROBE_DUP(MK_PROBE == 4 || MK_PROBE == 7, hgrn_pass1(F, layer));
#else
            if (F.gw < BATCH * NHEAD) fox_cscan(F, layer, F.gw);
#endif
        }
        END_STEP();
        if (RUN_STEP()) { STEP_PRO();
#if !MK_NAIVE_HGRN
            if (F.wave >= 4) { for (int bh = F.bx * 4 + (F.wave - 4); bh < BATCH * NHEAD; bh += F.G * 4) { PROBE_DUP(MK_PROBE == 4, fox_cscan(F, layer, bh)); }
                if (cv::Q_SC > 0 && F.G == 256 && F.bx >= 16) {
                    const int lo = (layer < 2 ? cv::D1N : cv::E3_LO + cv::D3N) + (layer & 1) * cv::Q_SC; LAS float* scr = (LAS float*)(F.lds + RING_OFF + F.wave * 16384);
                    for (int it = lo + (F.bx - 16) * 4 + (F.wave - 4); it < lo + cv::Q_SC; it += 240 * 4) conv_item(F, it, scr, F.lane); } }
            else { PROBE_DUP(MK_PROBE == 4 || MK_PROBE == 8, hgrn_scan(F)); }
#endif
        }
        END_STEP();
        if (RUN_STEP()) { STEP_PRO();
#if !MK_NAIVE_ATTN
            const attn_body::AttnTensors AT{(const attn_body::bf16*)zb, (const attn_body::bf16*)(zb + ZARR), (const attn_body::bf16*)(zb + 2 * ZARR), (const float*)(ws + WS_CB), KIN(F, 4) + layer * 512, (attn_body::bf16*)mix};
            const attn_body::StaticOrder S((int)F.G, F.bx);
            PROBE_DUP(MK_PROBE == 4 || MK_PROBE == 6, attn_body::attn_phase<attn_body::StaticOrder>((char*)lds + RING_OFF, AT, S, F.tid));
#endif
#if !MK_NAIVE_HGRN
            STEP_PRO(); PROBE_DUP(MK_PROBE == 4 || MK_PROBE == 9, hgrn_pass3(F, layer));
#endif
        }
        END_STEP();
        if (RUN_STEP()) { STEP_PRO();
            pg8::Gemm g{mix, (const bf16*)(ws + WS_WOUT) + (size_t)layer * D * D, M, D, D, D}; pg8::StaticOrder S; S.init(M, D, F.G, F.bx);
            typedef pg8::EpiRes<0, (long)WS_H8 - (long)WS_HB, 2> EpiOut8;
            if (!moe && F8DENSE(j)) { EpiOut8 E{hb, SSQ(par ^ 1)}; pg8::gemm_phase<EpiOut8, pg8::StaticOrder, true, true>(F.lds + RING_OFF, g, S, E, F.tid); }
            else { pg8::EpiRes<> E{hb, SSQ(par ^ 1)};
                if constexpr (MK_PROBE == 18) { pg8::EpiRes<> E0{(bf16*)(ws + WS_H + (16u << 20)), (float*)(ws + WS_H + (48u << 20))}; pg8::gemm_phase<pg8::EpiRes<>, pg8::StaticOrder, true, true>(F.lds + RING_OFF, g, S, E0, F.tid); STEP_PRO(); }
                pg8::gemm_phase<pg8::EpiRes<>, pg8::StaticOrder, true, true>(F.lds + RING_OFF, g, S, E, F.tid); }
        }
        par ^= 1;
        END_STEP();
        if (!moe) {
            if (RUN_STEP()) { STEP_PRO();
                pg8::StaticOrder S; S.init(M, 2 * DFF, F.G, F.bx);
                if (F8DENSE(j)) { pg8::Gemm g{(const bf16*)(ws + WS_H8), (const bf16*)(ws + WS_WGU) + (size_t)j * 2 * DFF * D, M, 2 * DFF, D / 2, D / 2};
                  pg8::EpiSwi8<true> E{(unsigned char*)(ws + WS_ACT), DFF, 1.0f / (F8_SX * F8_SWU), F8_SH, SSQ(par)};
                  PROBE_DUP(MK_PROBE == 15, pg8::gemm_phase<pg8::EpiSwi8<true>, pg8::StaticOrder, true, true, true>(F.lds + RING_OFF, g, S, E, F.tid));
                  if constexpr (MK_PROBE == 25) { int nv = (int)(s_lo >> 20); asm volatile("" : "+s"(nv)); pg8::EpiNull E0{(float*)(ws + WS_H + (16u << 20)), nv}; STEP_PRO();
                      pg8::gemm_phase<pg8::EpiNull, pg8::StaticOrder, true, true, true>(F.lds + RING_OFF, g, S, E0, F.tid); STEP_PRO(); pg8::gemm_phase<pg8::EpiNull, pg8::StaticOrder, true, true, true>(F.lds + RING_OFF, g, S, E0, F.tid); }
                  if constexpr (MK_PROBE == 23) { STEP_PRO(); pg8::gemm_phase<pg8::EpiSwi8<true>, pg8::StaticOrder, true, true, true>(F.lds + RING_OFF, g, S, E, F.tid); STEP_PRO(); pg8::gemm_phase<pg8::EpiSwi8<true>, pg8::StaticOrder, true, true, true>(F.lds + RING_OFF, g, S, E, F.tid); STEP_PRO(); pg8::gemm_phase<pg8::EpiSwi8<true>, pg8::StaticOrder, true, true, true>(F.lds + RING_OFF, g, S, E, F.tid); STEP_PRO(); pg8::gemm_phase<pg8::EpiSwi8<true>, pg8::StaticOrder, true, true, true>(F.lds + RING_OFF, g, S, E, F.tid); } }
                else { pg8::Gemm g{hb, (const bf16*)(ws + WS_WGU) + (size_t)j * 2 * DFF * D, M, 2 * DFF, D, D};
                  pg8::EpiSwi<true> E{(bf16*)(ws + WS_ACT), DFF, SSQ(par)};
                  PROBE_DUP(MK_PROBE == 3, pg8::gemm_phase<pg8::EpiSwi<true>, pg8::StaticOrder, true, true>(F.lds + RING_OFF, g, S, E, F.tid)); }
                if (F.G == 256 && F.bx >= 128) { STEP_PRO(); const int lo = layer == 0 ? cv::D1B : cv::E3_LO + cv::D3B, hi = layer == 0 ? cv::D1N : cv::E3_LO + cv::D3C; conv_range(F, lo, hi, F.bx - 128, 128); }
            }
            END_STEP();
            if (RUN_STEP()) { STEP_PRO();
                pg8::StaticOrder S; S.init(M, D, F.G, F.bx);
                if (F8DENSE(j)) { pg8::Gemm g{(const bf16*)(ws + WS_ACT), (const bf16*)(ws + WS_WD) + (size_t)j * D * DFF, M, D, DFF / 2, DFF / 2};
                  pg8::EpiRes<-10> E{hb, SSQ(par ^ 1)};
                  if constexpr (MK_PROBE == 19) { pg8::EpiRes<-10> E0{(bf16*)(ws + WS_H + (16u << 20)), (float*)(ws + WS_H + (48u << 20))}; pg8::gemm_phase<pg8::EpiRes<-10>, pg8::StaticOrder, true, true, true>(F.lds + RING_OFF, g, S, E0, F.tid); STEP_PRO(); }
                  pg8::gemm_phase<pg8::EpiRes<-10>, pg8::StaticOrder, true, true, true>(F.lds + RING_OFF, g, S, E, F.tid); }
                else { pg8::Gemm g{(const bf16*)(ws + WS_ACT), (const bf16*)(ws + WS_WD) + (size_t)j * D * DFF, M, D, DFF, DFF};
                  pg8::EpiRes<> E{hb, SSQ(par ^ 1)};
                  if constexpr (MK_PROBE == 19) { pg8::EpiRes<> E0{(bf16*)(ws + WS_H + (16u << 20)), (float*)(ws + WS_H + (48u << 20))}; pg8::gemm_phase<pg8::EpiRes<>, pg8::StaticOrder, true, true>(F.lds + RING_OFF, g, S, E0, F.tid); STEP_PRO(); }
                  pg8::gemm_phase<pg8::EpiRes<>, pg8::StaticOrder, true, true>(F.lds + RING_OFF, g, S, E, F.tid); }
            }
            par ^= 1;
            END_STEP();
        } else {
            if (RUN_STEP()) { STEP_PRO();
#if MK_TOUCH & 1
                mall_touch(F, WS_WEGU + (size_t)j * NE * 2 * DEXP * D * 2, (size_t)NE * 2 * DEXP * D * (F8LAYER(layer) ? 1 : 2)); STEP_PRO();
#endif
                PROBE_DUP(MK_PROBE == 5 || MK_PROBE == 12, moe_route_a(F, j)); }
            END_STEP();
            if (RUN_STEP()) { STEP_PRO();
#if MK_TOUCH & 2
                mall_touch(F, WS_WED + (size_t)j * NE * D * DEXP * 2, (size_t)NE * D * DEXP * (F8LAYER(layer) ? 1 : 2)); STEP_PRO();
#endif
                PROBE_DUP(MK_PROBE == 5, moe_route_b(F, F8LAYER(layer))); }
            END_STEP();
            if (RUN_STEP()) { STEP_PRO();
                const int* meta = (const int*)(ws + WS_META);
                pg8::MoeOrder S; S.nN = DEXP / 128; S.G = F.G; S.c = F.bx;
#pragma unroll
                for (int e = 0; e < 9; ++e) S.tpre[e] = __builtin_amdgcn_readfirstlane(meta[e]);
                S.nM = S.tpre[8]; S.nwg = S.nM * S.nN; S.nlim = S.nwg;
                if (F8LAYER(layer)) {
                    pg8::Gemm g{(const bf16*)(ws + WS_XG), (const bf16*)(ws + WS_WEGU) + (size_t)j * NE * 2 * DEXP * D, SLOTS, 2 * DEXP, D / 2, D / 2};
                    pg8::EpiSwi8<false> E{(unsigned char*)(ws + WS_HGB), DEXP, 1.0f / (F8_SX * F8_SWU), F8_SH, nullptr};
                    if constexpr (MK_PROBE == 24) { int nv = (int)(s_lo >> 20); asm volatile("" : "+s"(nv)); pg8::EpiNull E0{(float*)(ws + WS_HGB) + (size_t)SLOTS * DEXP / 4, nv};
                        pg8::gemm_phase<pg8::EpiNull, pg8::MoeOrder, true, true, true>(F.lds + RING_OFF, g, S, E0, F.tid); STEP_PRO(); }
                    if constexpr (MK_PROBE == 21 || MK_PROBE == 22) { pg8::EpiSwi8<false> E0{(unsigned char*)(ws + WS_HGB) + (size_t)SLOTS * DEXP, DEXP, 1.0f / (F8_SX * F8_SWU), F8_SH, nullptr}; pg8::MoeOrder S0 = S; S0.emask = (MK_PROBE == 21) ? 0 : 7;
                        pg8::gemm_phase<pg8::EpiSwi8<false>, pg8::MoeOrder, true, true, true>(F.lds + RING_OFF, g, S0, E0, F.tid); STEP_PRO(); }
                    PROBE_DUP(MK_PROBE == 13, pg8::gemm_phase<pg8::EpiSwi8<false>, pg8::MoeOrder, true, true, true>(F.lds + RING_OFF, g, S, E, F.tid));
                } else {
                pg8::Gemm g{(const bf16*)(ws + WS_XG), (const bf16*)(ws + WS_WEGU) + (size_t)j * NE * 2 * DEXP * D, SLOTS, 2 * DEXP, D, D};
                pg8::EpiSwi<false> E{(bf16*)(ws + WS_HGB), DEXP, nullptr};
                PROBE_DUP(MK_PROBE == 2, pg8::gemm_phase<pg8::EpiSwi<false>, pg8::MoeOrder, true, true>(F.lds + RING_OFF, g, S, E, F.tid));
                }
                if (F.G == 256 && layer == 1) { const int rounds = (S.nwg + 255) / 256, c0 = S.nwg - (rounds - 1) * 256, nidle = 256 - c0; const bool all = nidle < 96;
                    if (all || F.bx >= c0) { STEP_PRO(); const int lo = cv::E3_LO + cv::D3C; conv_range(F, lo, lo + cv::Q_MUP, all ? F.bx : F.bx - c0, all ? 256 : nidle); } }
            }
            END_STEP();
            if (RUN_STEP()) { STEP_PRO();
                const int* meta = (const int*)(ws + WS_META);
                pg8::MoeOrder S; S.nN = D / 256; S.G = F.G; S.c = F.bx;
#pragma unroll
                for (int e = 0; e < 9; ++e) S.tpre[e] = __builtin_amdgcn_readfirstlane(meta[e]);
                S.nM = S.tpre[8]; S.nwg = S.nM * S.nN;
                int L0, nleft; pg8::moe_split_plan(S.nwg, F.G, L0, nleft); S.nlim = L0;
                if (F8LAYER(layer)) {
                    pg8::Gemm g{(const bf16*)(ws + WS_HGB), (const bf16*)(ws + WS_WED) + (size_t)j * NE * D * DEXP, SLOTS, D, DEXP / 2, DEXP / 2};
                    pg8::EpiPlain E{(bf16*)(ws + WS_XG), D, 1.0f / (F8_SH * F8_SWD)};
                    if constexpr (MK_PROBE == 26) { int nv = (int)(s_lo >> 20); asm volatile("" : "+s"(nv)); pg8::EpiNull E0{(float*)(ws + WS_H + (16u << 20)), nv};
                        pg8::gemm_phase<pg8::EpiNull, pg8::MoeOrder, true, true, true>(F.lds + RING_OFF, g, S, E0, F.tid); STEP_PRO(); pg8::gemm_phase<pg8::EpiNull, pg8::MoeOrder, true, true, true>(F.lds + RING_OFF, g, S, E0, F.tid); STEP_PRO(); }
                    PROBE_DUP(MK_PROBE == 14, pg8::gemm_phase<pg8::EpiPlain, pg8::MoeOrder, true, true, true>(F.lds + RING_OFF, g, S, E, F.tid));
                    if (nleft > 0) { STEP_PRO();
                        const int split = nleft * 7 <= (int)F.G ? 7 : 2;
                        pg8::LeftOrder S2; S2.base = S; S2.L0 = L0; S2.nleft = nleft; S2.c = F.bx; S2.kq_len = DEXP / 2 / split; S2.split = split;
                        pg8::Gemm g2{(const bf16*)(ws + WS_HGB), (const bf16*)(ws + WS_WED) + (size_t)j * NE * D * DEXP, SLOTS, D, DEXP / 2 / split, DEXP / 2};
                        pg8::EpiPlainSplit E2{(bf16*)(ws + WS_XG), (bf16*)(ws + WS_YP), 1.0f / (F8_SH * F8_SWD), split - 1};
                        PROBE_DUP(MK_PROBE == 14, pg8::gemm_phase<pg8::EpiPlainSplit, pg8::LeftOrder, true, true, true>(F.lds + RING_OFF, g2, S2, E2, F.tid)); }
                } else {
                pg8::Gemm g{(const bf16*)(ws + WS_HGB), (const bf16*)(ws + WS_WED) + (size_t)j * NE * D * DEXP, SLOTS, D, DEXP, DEXP};
                pg8::EpiPlain E{(bf16*)(ws + WS_XG), D, 1.0f};
                PROBE_DUP(MK_PROBE == 2, pg8::gemm_phase<pg8::EpiPlain, pg8::MoeOrder, true, true>(F.lds + RING_OFF, g, S, E, F.tid));
                if (nleft > 0) { STEP_PRO();
                    pg8::LeftOrder S2; S2.base = S; S2.L0 = L0; S2.nleft = nleft; S2.c = F.bx; S2.kq_len = DEXP / 4; S2.split = 4;
                    pg8::Gemm g2{(const bf16*)(ws + WS_HGB), (const bf16*)(ws + WS_WED) + (size_t)j * NE * D * DEXP, SLOTS, D, DEXP / 4, DEXP};
                    pg8::EpiPlainSplit E2{(bf16*)(ws + WS_XG), (bf16*)(ws + WS_YP), 1.0f, 3};
                    pg8::gemm_phase<pg8::EpiPlainSplit, pg8::LeftOrder, true, true>(F.lds + RING_OFF, g2, S2, E2, F.tid); }
                }
            }
            END_STEP();
            if (RUN_STEP()) { STEP_PRO(); moe_combine(F, SSQ(par ^ 1), F8LAYER(layer)); }
            par ^= 1;
            END_STEP();
        }
        if (RUN_STEP()) { STEP_PRO();
            { pg8::Gemm g{(const bf16*)(ws + WS_PB) + (size_t)layer * M * DPLE, (const bf16*)(ws + WS_WPLE) + (size_t)layer * D * DPLE, M, D, DPLE, DPLE}; pg8::StaticOrder S; S.init(M, D, F.G, F.bx);
              pg8::EpiP2 E{(bf16*)(ws + WS_P2)};
              PROBE_DUP(MK_PROBE == 16, pg8::gemm_phase<pg8::EpiP2, pg8::StaticOrder, true, true>(F.lds + RING_OFF, g, S, E, F.tid)); }
            STEP_PRO();
            { pg8::Gemm g{hb, (const bf16*)(ws + WS_WPG) + (size_t)layer * D * D, M, D, D, D}; pg8::StaticOrder S; S.init(M, D, F.G, F.bx);
              typedef pg8::EpiPleT<(long)WS_H8 - (long)WS_HB, 2> EpiPle8;
              if (layer + 1 < DEPTH && F8IN(layer + 1)) { EpiPle8 E{(const bf16*)(ws + WS_P2), hb, SSQ(par), SSQ(par ^ 1)}; pg8::gemm_phase<EpiPle8, pg8::StaticOrder, true, true>(F.lds + RING_OFF, g, S, E, F.tid); }
              else { pg8::EpiPle E{(const bf16*)(ws + WS_P2), hb, SSQ(par), SSQ(par ^ 1)};
                if constexpr (MK_PROBE == 20) { pg8::EpiPle E0{(const bf16*)(ws + WS_P2), (bf16*)(ws + WS_H + (16u << 20)), SSQ(par), (float*)(ws + WS_H + (48u << 20))}; pg8::gemm_phase<pg8::EpiPle, pg8::StaticOrder, true, true>(F.lds + RING_OFF, g, S, E0, F.tid); STEP_PRO(); }
                pg8::gemm_phase<pg8::EpiPle, pg8::StaticOrder, true, true>(F.lds + RING_OFF, g, S, E, F.tid); } }
        }
        par ^= 1;
        END_STEP();
    }
    if (RUN_STEP()) { STEP_PRO(); PROBE_DUP(MK_PROBE == 17, final_norm(F)); }
    END_STEP();
#undef RUN_STEP
#undef hb
#undef h
#undef ssq0
#undef zb
#undef mix
#undef END_STEP
#undef SSQ
}

extern "C" void kernel_launch(void* const* d_in, const int* in_sizes, int n_in, void* d_out, int out_size, void* d_ws, size_t ws_size, hipStream_t stream) {
    static int grid = 0;
    if (grid == 0) {
        if (n_in != 21 || out_size != M * D || ws_size < WS_END) { fprintf(stderr, "kernel_launch: unexpected problem (n_in %d out %d ws %zu need %zu)\n", n_in, out_size, ws_size, (size_t)WS_END); grid = -1; return; }
        int dev = 0, cus = 0, per_cu = 0;
        if (hipGetDevice(&dev) != hipSuccess || hipDeviceGetAttribute(&cus, hipDeviceAttributeMultiprocessorCount, dev) != hipSuccess) { grid = -1; return; }
        if (hipFuncSetAttribute((const void*)mk_fwd, hipFuncAttributeMaxDynamicSharedMemorySize, LDS_BYTES) != hipSuccess) { grid = -1; return; }
        if (hipOccupancyMaxActiveBlocksPerMultiprocessor(&per_cu, (const void*)mk_fwd, NWAVES * 64, LDS_BYTES) != hipSuccess || per_cu < 1) { fprintf(stderr, "kernel_launch: occupancy query says %d\n", per_cu); }
        (void)hipGetLastError();
        grid = cus;
    }
    if (grid < 0) return;
    (void)hipMemsetAsync((char*)d_ws + WS_CTL, 0, CTL_ZERO_BYTES, stream);
    Args a{};
    for (int i = 0; i < 21; ++i) a.in[i] = (const float*)d_in[i];
    a.out = (float*)d_out; a.ws = (unsigned char*)d_ws;
#if MK_ONE_LAUNCH
    a.s_lo = 0; a.s_hi = total_steps(); a.li = 0;
    hipLaunchKernelGGL(mk_fwd, dim3(grid), dim3(NWAVES * 64), LDS_BYTES, stream, a);
#else
    int step = 0, li = 0;
    auto launch1 = [&](int s) { a.s_lo = s; a.s_hi = s + 1; a.li = li % MAX_BAR_REGIONS; ++li; hipLaunchKernelGGL(mk_fwd, dim3(grid), dim3(NWAVES * 64), LDS_BYTES, stream, a); };
    launch1(step++);
    for (int layer = 0; layer < DEPTH; ++layer) {
        const int n = steps_per_layer(layer);
        for (int k = 0; k < n; ++k) {
            launch1(step++);
            if (k == 1) {
                const bf16* zb = (const bf16*)((char*)d_ws + WS_ZB); bf16* mix = (bf16*)((char*)d_ws + WS_MIX);
                (void)zb; (void)mix;
#if MK_NAIVE_ATTN
                k_fox_attn_n<<<dim3(SEQ / 256, BATCH * NHEAD), 256, 0, stream>>>(zb, (const float*)((char*)d_ws + WS_CB), (const float*)d_in[4] + layer * 512, mix);
#endif
#if MK_NAIVE_HGRN
                k_hgrn_n<<<BATCH * NHEAD, 64, 0, stream>>>(zb, (const float*)((char*)d_ws + WS_LB) + layer * 512, (const float*)d_in[6] + layer * 512, mix);
#endif
            }
        }
    }
    launch1(step++);
#endif
}
```

```cpp
#include <hip/hip_runtime.h>
#include <cstdio>
#include <cstdint>
#define MK_NAIVE_ATTN 0
#define MK_NAIVE_HGRN 0
#define MK_ONE_LAUNCH 1
#define MK_PROBE 0
#define MK_FP8_LAST 1
#define MK_FP8_L1 1
#define MK_FP8_DENSE 2
#define MK_TOUCH 0
#define MK_MOE_WGM 8
#define MK_RES_TOUCH 0
#define MK_RELAX_WAIT 0
#define MK_Q_IN 4500
#define MK_Q_IN8 2800
#define MK_Q_UP 9000
#define MK_Q_UP8 5600
#define MK_Q_SC 1920
#define MK_QB 1536
#define MK_MFMA_NOSCALE 1
#define MK_NT 1
#define MK_PKZERO 1
#define MK_LT16 1
#define MK_TRREAD 1
#define MK_SCAN4 1
#define MK_WGM 4
#define MK_FP8_IN 8
#define F8IN(i) (MK_FP8_IN != 0 && ((MK_FP8_IN >> (i)) & 1))
#define F8DENSE(j) (MK_FP8_DENSE == 3 || (MK_FP8_DENSE != 0 && ((MK_FP8_DENSE >> (j)) & 1)))
namespace pg8 {
#define PG8_LAS __attribute__((address_space(3)))
typedef unsigned short bf16_t;
typedef short bf16x8 __attribute__((ext_vector_type(8)));
typedef float f32x4 __attribute__((ext_vector_type(4)));
typedef unsigned u32x4 __attribute__((ext_vector_type(4)));
constexpr int BM = 256, BK = 64, HALF = 128, HTB = HALF * BK * 2  , STAGE_BYTES = 8 * HTB, NXCD = 8, WGM = MK_WGM;

__host__ __device__ __forceinline__ int lds_byte(int r, int c) { const int st = (r >> 4) * 2 + (c >> 5), rr = r & 15, cc = c & 31, ob = rr * 64 + cc * 2; return st * 1024 + (ob ^ (((ob >> 9) & 1) << 5)); }
__host__ __device__ __forceinline__ void stage_rc(int b, int& R, int& C) { const int st = b / 1024, sb = b % 1024, swz = sb ^ (((sb >> 9) & 1) << 5); R = (st >> 1) * 16 + swz / 64; C = (st & 1) * 32 + (swz % 64) / 2; }
__host__ __device__ __forceinline__ int perm32(int rho) { const int n = rho >> 4, i = rho & 15; return 8 * (i >> 2) + 4 * n + (i & 3); }

__device__ __forceinline__ int pg8_lane_volatile() { int l; asm volatile("v_mbcnt_lo_u32_b32 %0, -1, 0\n\tv_mbcnt_hi_u32_b32 %0, -1, %0" : "=v"(l)); return l; }
struct Unit { int pm, pn, pb, koff, tag; };
struct Gemm { const bf16_t* A; const bf16_t* Bt; int M, N, K, ld; };

struct StaticOrder {
    int nM, nN, nwg, G, c;
    __host__ __device__ void init(int M, int N, int G_, int c_) { nM = M / BM; nN = N / BM; nwg = nM * nN; G = G_; c = c_; }
    __host__ __device__ bool next(int i, Unit& u) const {
        const long L = (long)i * G + c; if (L >= nwg) return false;
        int wgid = (int)L; { const int q = nwg / NXCD, r = nwg % NXCD, xcd = wgid % NXCD, off = wgid / NXCD; wgid = (xcd < r ? xcd * (q + 1) : r * (q + 1) + (xcd - r) * q) + off; }
        const int nig = WGM * nN, gid = wgid / nig, fm = gid * WGM, gsz = (nM - fm) < WGM ? (nM - fm) : WGM;
        u.pm = fm + ((wgid % nig) % gsz); u.pn = (wgid % nig) / gsz; u.pb = u.pn; u.koff = 0; u.tag = 0; return true;
    }
    __device__ __forceinline__ void a_ready(const Unit&) const {}
    __device__ __forceinline__ void done(const Unit&) const {}
};

__device__ __forceinline__ unsigned cvt_pk_bf16(float lo, float hi) { unsigned r; asm volatile("v_cvt_pk_bf16_f32 %0, %1, %2" : "=v"(r) : "v"(lo), "v"(hi)); return r; }
typedef float f32x2 __attribute__((ext_vector_type(2)));
typedef int i32x4_t __attribute__((ext_vector_type(4)));
template <class Epi, class Sched, bool ALIGN_EPI = false, bool SP2 = false, bool F8 = false>
__device__ __forceinline__ void gemm_phase(PG8_LAS unsigned char* lds, const Gemm g, const Sched& S, const Epi& E, const int tid_in) {
    int tid_o = tid_in; asm volatile("" : "+v"(tid_o));
    const int tid = tid_o, wid = __builtin_amdgcn_readfirstlane(tid >> 6), lane = tid & 63, wr = wid >> 2, wc = wid & 3, fr = lane & 15, fq = lane >> 4;
    const int K = g.ld, nt = g.K / BK;
    unsigned voffA[1], voffB[1];
    { int R, C; stage_rc(tid * 16, R, C); const int Rb = Epi::PERM ? ((R & ~31) + perm32(R & 31)) : R;
      voffA[0] = (unsigned)(R * K + C) * 2u; voffB[0] = (unsigned)(Rb * K + C) * 2u; }
    const size_t rstep64 = (size_t)64 * K * 2;
    const size_t kstep = (size_t)(BK * 2);
    const size_t hstep = (size_t)HALF * K * 2;
    const size_t tstep = 2 * hstep;
    const unsigned ldsw = (unsigned)wid * 1024u;
    const int aoff = lds_byte(wr * 64 + fr, fq * 8), boff = lds_byte(wc * 32 + fr, fq * 8);
#define PG8_SA(b, h) (((b) * 2 + (h)) * HTB)
#define PG8_SB(b, h) ((4 + (b) * 2 + (h)) * HTB)
#define PG8_STAGE(bufoff, gbase, voff) do { _Pragma("unroll") for (int _i = 0; _i < 2; ++_i)   \
        __builtin_amdgcn_global_load_lds((const unsigned*)((const char*)(gbase) + (size_t)_i * rstep64 + (voff)[0]), (PG8_LAS unsigned*)(lds + (bufoff) + ldsw + _i * 8192), 16, 0, 0); } while (0)
#define PG8_LDA(dst, b, h) do { _Pragma("unroll") for (int m = 0; m < 4; ++m) _Pragma("unroll") for (int k = 0; k < 2; ++k) dst[m][k] = *(const PG8_LAS bf16x8*)(lds + PG8_SA(b, h) + aoff + m * 2048 + k * 1024); } while (0)
#define PG8_LDB(dst, b, h) do { _Pragma("unroll") for (int n = 0; n < 2; ++n) _Pragma("unroll") for (int k = 0; k < 2; ++k) dst[n][k] = *(const PG8_LAS bf16x8*)(lds + PG8_SB(b, h) + boff + n * 2048 + k * 1024); } while (0)
#define PG8_CAT8(lo, hi) __builtin_shufflevector(__builtin_bit_cast(i32x4_t, lo), __builtin_bit_cast(i32x4_t, hi), 0, 1, 2, 3, 4, 5, 6, 7)
#define PG8_MMA(ai, bj, At, Bt) do { __builtin_amdgcn_s_setprio(1); \
        if constexpr (F8) {   \
            _Pragma("unroll") for (int n = 0; n < 2; ++n) { const auto b8_ = PG8_CAT8(Bt[n][0], Bt[n][1]); \
                _Pragma("unroll") for (int m = 0; m < 4; ++m) { const auto a8_ = PG8_CAT8(At[m][0], At[m][1]);   \
                    if constexpr (MK_MFMA_NOSCALE) asm volatile("v_mfma_f32_16x16x128_f8f6f4 %0, %1, %2, %0" : "+v"(acc[ai][bj][m][n]) : "v"(b8_), "v"(a8_));   \
                    else asm volatile("v_mfma_scale_f32_16x16x128_f8f6f4 %0, %1, %2, %0, %3, %3 op_sel_hi:[0,0,0]" : "+v"(acc[ai][bj][m][n]) : "v"(b8_), "v"(a8_), "v"(f8one)); } } } \
        else { _Pragma("unroll") for (int m = 0; m < 4; ++m) _Pragma("unroll") for (int n = 0; n < 2; ++n) _Pragma("unroll") for (int k = 0; k < 2; ++k) \
            acc[ai][bj][m][n] = __builtin_amdgcn_mfma_f32_16x16x32_bf16(Bt[n][k], At[m][k], acc[ai][bj][m][n], 0, 0, 0); } \
        __builtin_amdgcn_s_setprio(0); } while (0)
#define PG8_WAIT_V(n) asm volatile("s_waitcnt vmcnt(" #n ")" ::: "memory")
#define PG8_WAIT_L(n) asm volatile("s_waitcnt lgkmcnt(" #n ")" ::: "memory")
#define PG8_WAIT_VN(n) asm volatile("s_waitcnt vmcnt(%0)" :: "n"(n) : "memory")
#define PG8_BAR __builtin_amdgcn_s_barrier()
#define PG8_SCHED __builtin_amdgcn_sched_barrier(0)
    Unit cur, nxt; int ui = 0; bool epi_stores = false;
    if (!S.next(0, cur)) return;
    int f8one = 0x7f7f7f7f; if constexpr (F8) asm volatile("" : "+v"(f8one));
    typedef float f32x2z __attribute__((ext_vector_type(2)));
    f32x2z zz2 = {0.f, 0.f}; asm volatile("" : "+v"(zz2));
    f32x4 acc[2][2][4][2];
#pragma unroll
    for (int a = 0; a < 2; ++a)
#pragma unroll
        for (int b = 0; b < 2; ++b)
#pragma unroll
            for (int m = 0; m < 4; ++m)
#pragma unroll
                for (int n = 0; n < 2; ++n) { if constexpr (MK_PKZERO) acc[a][b][m][n] = __builtin_shufflevector(zz2, zz2, 0, 1, 0, 1);
                    else { float z_ = 0.f; if constexpr (F8) asm volatile("" : "+v"(z_)); acc[a][b][m][n] = (f32x4){z_, z_, z_, z_}; } }
    bf16x8 At[4][2], B0[2][2], B1[2][2];
    const char* cA = (const char*)g.A + (size_t)cur.pm * tstep + (size_t)cur.koff * 2; const char* cB = (const char*)g.Bt + (size_t)cur.pb * tstep + (size_t)cur.koff * 2;
    S.a_ready(cur);
    PG8_LAS float* const rtab = (PG8_LAS float*)(lds + STAGE_BYTES + 2048);
    bool pre_all = false;
    if constexpr (Epi::HAS_PREP) { Unit uu; pre_all = !S.next(8, uu);
        if (pre_all) { for (int i = 0; i < 8 && S.next(i, uu); ++i) E.prep(rtab + i * 256, uu, tid); }
        else E.prep(rtab, cur, tid); }
#if MK_RES_TOUCH
    if constexpr (Epi::TOUCH) {
        const char* rb = (const char*)E.hb + ((size_t)cur.pm * BM * 1024 + (size_t)cur.pn * BM) * 2;
#pragma unroll
        for (int i = 0; i < 4; ++i) { const int idx = i * 512 + tid; __builtin_amdgcn_global_load_lds((const unsigned*)(rb + (size_t)(idx >> 3) * 2048 + (idx & 7) * 64), (PG8_LAS unsigned*)(lds + STAGE_BYTES + 12288 + wid * 256), 4, 0, 0); }
    }
#endif
    if constexpr (SP2) {
        PG8_STAGE(PG8_SB(0, 0), cB, voffB); PG8_STAGE(PG8_SB(0, 1), cB + hstep, voffB); PG8_STAGE(PG8_SA(0, 0), cA, voffA); PG8_STAGE(PG8_SA(0, 1), cA + hstep, voffA);
        if (wr == 1) PG8_BAR;
        PG8_WAIT_V(2); PG8_BAR;
        PG8_STAGE(PG8_SB(1, 0), cB + kstep, voffB); PG8_STAGE(PG8_SA(1, 0), cA + kstep, voffA); PG8_STAGE(PG8_SB(1, 1), cB + hstep + kstep, voffB);
        PG8_WAIT_V(6); PG8_BAR;
    } else {
        PG8_STAGE(PG8_SB(0, 0), cB, voffB); PG8_STAGE(PG8_SA(0, 0), cA, voffA); PG8_STAGE(PG8_SB(0, 1), cB + hstep, voffB); PG8_STAGE(PG8_SA(0, 1), cA + hstep, voffA);
        if (wr == 1) PG8_BAR;
        PG8_WAIT_V(4); PG8_BAR;
        PG8_STAGE(PG8_SB(1, 0), cB + kstep, voffB); PG8_STAGE(PG8_SA(1, 0), cA + kstep, voffA); PG8_STAGE(PG8_SB(1, 1), cB + hstep + kstep, voffB);
        PG8_WAIT_V(6); PG8_BAR;
    }
    for (;;) {
        const bool has_next = S.next(ui + 1, nxt);
        const char* nA = has_next ? (const char*)g.A + (size_t)nxt.pm * tstep + (size_t)nxt.koff * 2 : cA; const char* nB = has_next ? (const char*)g.Bt + (size_t)nxt.pb * tstep + (size_t)nxt.koff * 2 : cB;
#pragma unroll 1
        for (int t = 0; t < nt; t += 2) {
            const bool last = (t == nt - 2);
            const char* a1 = cA + (size_t)(t + 1) * kstep;
            const char* a2 = last ? nA : cA + (size_t)(t + 2) * kstep; const char* b2 = last ? nB : cB + (size_t)(t + 2) * kstep;
            const char* a3 = a2 + kstep; const char* b3 = b2 + kstep;
            if (last && has_next) S.a_ready(nxt);
            if constexpr (SP2) {
            const bool rlx = MK_RELAX_WAIT && Epi::NST > 0 && t == 0 && epi_stores;
            PG8_LDB(B0, 0, 0); PG8_LDB(B1, 0, 1); PG8_SCHED; PG8_LDA(At, 0, 0); PG8_STAGE(PG8_SA(1, 1), a1 + hstep, voffA);
            if (rlx) PG8_WAIT_VN(8 + Epi::NST); else PG8_WAIT_V(8);
            PG8_WAIT_L(0); PG8_BAR; PG8_MMA(0, 0, At, B0); PG8_MMA(0, 1, At, B1); PG8_BAR; PG8_SCHED;
            PG8_LDA(At, 0, 1); PG8_STAGE(PG8_SB(0, 0), b2, voffB); PG8_STAGE(PG8_SB(0, 1), b2 + hstep, voffB); PG8_STAGE(PG8_SA(0, 0), a2, voffA);
            if (rlx) PG8_WAIT_VN(8 + Epi::NST); else PG8_WAIT_V(8);
            PG8_WAIT_L(0); PG8_BAR; PG8_MMA(1, 0, At, B0); PG8_MMA(1, 1, At, B1); PG8_BAR; PG8_SCHED;
            PG8_LDB(B0, 1, 0); PG8_LDB(B1, 1, 1); PG8_SCHED; PG8_LDA(At, 1, 0); PG8_STAGE(PG8_SA(0, 1), a2 + hstep, voffA);
            PG8_WAIT_V(8); PG8_WAIT_L(0); PG8_BAR; PG8_MMA(0, 0, At, B0); PG8_MMA(0, 1, At, B1); PG8_BAR; PG8_SCHED;
            PG8_LDA(At, 1, 1); PG8_STAGE(PG8_SB(1, 0), b3, voffB); PG8_STAGE(PG8_SB(1, 1), b3 + hstep, voffB); PG8_STAGE(PG8_SA(1, 0), a3, voffA);
            PG8_WAIT_V(8); PG8_WAIT_L(0); PG8_BAR; PG8_MMA(1, 0, At, B0); PG8_MMA(1, 1, At, B1); PG8_BAR; PG8_SCHED;
            } else {
            PG8_LDB(B0, 0, 0); PG8_SCHED; PG8_LDA(At, 0, 0); PG8_STAGE(PG8_SA(1, 1), a1 + hstep, voffA);
            PG8_WAIT_L(8); PG8_BAR; PG8_WAIT_L(0); PG8_MMA(0, 0, At, B0); PG8_BAR; PG8_SCHED;
            PG8_LDB(B1, 0, 1); PG8_STAGE(PG8_SB(0, 0), b2, voffB);
            PG8_BAR; PG8_WAIT_L(0); PG8_MMA(0, 1, At, B1); PG8_BAR;
            PG8_LDA(At, 0, 1); PG8_STAGE(PG8_SA(0, 0), a2, voffA);
            PG8_BAR; PG8_WAIT_L(0); PG8_MMA(1, 0, At, B0); PG8_BAR; PG8_SCHED;
            PG8_STAGE(PG8_SB(0, 1), b2 + hstep, voffB);
            PG8_WAIT_V(6); PG8_BAR; PG8_MMA(1, 1, At, B1); PG8_BAR;
            PG8_LDB(B0, 1, 0); PG8_SCHED; PG8_LDA(At, 1, 0); PG8_STAGE(PG8_SA(0, 1), a2 + hstep, voffA);
            PG8_WAIT_L(8); PG8_BAR; PG8_WAIT_L(0); PG8_MMA(0, 0, At, B0); PG8_BAR; PG8_SCHED;
            PG8_LDB(B1, 1, 1); PG8_STAGE(PG8_SB(1, 0), b3, voffB);
            PG8_BAR; PG8_WAIT_L(0); PG8_MMA(0, 1, At, B1); PG8_BAR;
            PG8_LDA(At, 1, 1); PG8_STAGE(PG8_SA(1, 0), a3, voffA);
            PG8_BAR; PG8_WAIT_L(0); PG8_MMA(1, 0, At, B0); PG8_BAR; PG8_SCHED;
            PG8_STAGE(PG8_SB(1, 1), b3 + hstep, voffB);
            PG8_WAIT_V(6); PG8_BAR; PG8_MMA(1, 1, At, B1); PG8_BAR;
            }
        }
        if constexpr (ALIGN_EPI) { if (wr == 0) PG8_BAR; }
        if constexpr (F8) asm volatile("s_nop 15\n\ts_nop 15" ::: "memory");
        if constexpr (!Epi::AFTER_DRAIN) { if constexpr (Epi::HAS_PREP) { if (has_next && !pre_all) E.prep(rtab + ((ui + 1) & 1) * 256, nxt, wid * 64 + pg8_lane_volatile()); }
            const int l2_ = pg8_lane_volatile(); E(acc, cur, wr, wc, l2_ & 15, l2_ >> 4, rtab + (pre_all ? ui : (ui & 1)) * 256); S.done(cur); }
        if (!has_next) break;
        zz2 = (f32x2z){0.f, 0.f}; asm volatile("" : "+v"(zz2));
#pragma unroll
        for (int a = 0; a < 2; ++a)
#pragma unroll
            for (int b = 0; b < 2; ++b)
#pragma unroll
                for (int m = 0; m < 4; ++m)
#pragma unroll
                    for (int n = 0; n < 2; ++n) { if constexpr (MK_PKZERO) acc[a][b][m][n] = __builtin_shufflevector(zz2, zz2, 0, 1, 0, 1);
                    else { float z_ = 0.f; if constexpr (F8) asm volatile("" : "+v"(z_)); acc[a][b][m][n] = (f32x4){z_, z_, z_, z_}; } }
        epi_stores = E.nst_ok(cur); cur = nxt; cA = nA; cB = nB; ++ui;
        if constexpr (ALIGN_EPI) { if (wr == 1) PG8_BAR; }
    }
    PG8_WAIT_V(0);
    if constexpr (!ALIGN_EPI) { if (wr == 0) PG8_BAR; }
    PG8_BAR;
    if constexpr (Epi::AFTER_DRAIN) { E.fused(acc, cur, wr, wc, fr, fq, lds, wid, lane); S.done(cur); }
#undef PG8_SA
#undef PG8_SB
#undef PG8_STAGE
#undef PG8_LDA
#undef PG8_LDB
#undef PG8_MMA
#undef PG8_CAT8
#undef PG8_WAIT_V
#undef PG8_WAIT_L
#undef PG8_WAIT_VN
#undef PG8_BAR
#undef PG8_SCHED
}
}
namespace pg8 {
constexpr float RMS_EPS = 1e-6f;
typedef unsigned u32x2 __attribute__((ext_vector_type(2)));
constexpr int SSQ_M = 16384;
__device__ __forceinline__ float sigm_f(float g) { return __builtin_amdgcn_rcpf(1.f + __builtin_amdgcn_exp2f(-1.4426950408889634f * g)); }
__device__ __forceinline__ float silu_f(float g) { return g * sigm_f(g); }
__device__ __forceinline__ f32x4 swiglu4(const f32x4 ag, const f32x4 au, const float k1, const float k2) {
    const f32x4 t = ag * k1; f32x4 ex;
    ex[0] = __builtin_amdgcn_exp2f(t[0]); ex[1] = __builtin_amdgcn_exp2f(t[1]); ex[2] = __builtin_amdgcn_exp2f(t[2]); ex[3] = __builtin_amdgcn_exp2f(t[3]);
    const f32x4 d = ex + 1.0f; f32x4 r;
    r[0] = __builtin_amdgcn_rcpf(d[0]); r[1] = __builtin_amdgcn_rcpf(d[1]); r[2] = __builtin_amdgcn_rcpf(d[2]); r[3] = __builtin_amdgcn_rcpf(d[3]);
    return ((ag * au) * k2) * r;
}
__device__ __forceinline__ float bf2f(unsigned short h) { return __uint_as_float((unsigned)h << 16); }
__device__ __forceinline__ f32x4 bf4x(u32x2 w) { f32x4 r; r[0] = __uint_as_float(w.x << 16); r[1] = __uint_as_float(w.x & 0xffff0000u); r[2] = __uint_as_float(w.y << 16); r[3] = __uint_as_float(w.y & 0xffff0000u); return r; }

__device__ __forceinline__ float add_xor1(float v) { return v + __builtin_bit_cast(float, __builtin_amdgcn_update_dpp(0, __builtin_bit_cast(int, v), 0xB1, 0xf, 0xf, true)); }
__device__ __forceinline__ float add_xor2(float v) { return v + __builtin_bit_cast(float, __builtin_amdgcn_update_dpp(0, __builtin_bit_cast(int, v), 0x4E, 0xf, 0xf, true)); }
__device__ __forceinline__ float add_xor4(float v) { return v + __builtin_bit_cast(float, __builtin_amdgcn_ds_swizzle(__builtin_bit_cast(int, v), 0x101F)); }
__device__ __forceinline__ float add_xor16(float v) { return v + __builtin_bit_cast(float, __builtin_amdgcn_ds_swizzle(__builtin_bit_cast(int, v), 0x401F)); }
__device__ __forceinline__ float add_xor32(float v) { const auto r = __builtin_amdgcn_permlane32_swap(__float_as_uint(v), __float_as_uint(v), false, false); return __uint_as_float(r[0]) + __uint_as_float(r[1]); }
__device__ __forceinline__ void prep_rstd(PG8_LAS float* tab, const float* ssq, int pm, int tid) {
    const int r = tid >> 1, hf = tid & 1; const float* p = ssq + (size_t)(hf * 8) * SSQ_M + pm * BM + r; float a[8];
#pragma unroll
    for (int i = 0; i < 8; ++i) a[i] = p[(size_t)i * SSQ_M];
    float s = ((a[0] + a[1]) + (a[2] + a[3])) + ((a[4] + a[5]) + (a[6] + a[7])); s = add_xor1(s);
    if (hf == 0) tab[r] = rsqrtf(s * (1.0f / 1024.0f) + RMS_EPS);
}
template <int SCALE_LOG2 = 0> struct EpiInT {
    static constexpr bool TOUCH = false, PERM = true, AFTER_DRAIN = false, HAS_PREP = true;
    static constexpr int NST = 16;
    __device__ __forceinline__ bool nst_ok(const Unit& u) const { return u.pn != 14; }
    __device__ __forceinline__ void prep(PG8_LAS float* tab, const Unit& u, int tid) const { prep_rstd(tab, ssq, u.pm, tid); }
    bf16_t* zb; size_t arr_stride; float* fg; const float* ssq; float qscale;
    __device__ __forceinline__ void operator()(const f32x4 (&acc)[2][2][4][2], const Unit& u, int wr, int wc, int fr, int fq, const PG8_LAS float* rtab) const {
        const int row0 = u.pm * BM + wr * 64 + fr;
#pragma unroll
        for (int ai = 0; ai < 2; ++ai)
#pragma unroll
            for (int m = 0; m < 4; ++m) {
                const int row = row0 + ai * HALF + m * 16; const float rs = SCALE_LOG2 == 0 ? rtab[ai * HALF + wr * 64 + m * 16 + fr] : rtab[ai * HALF + wr * 64 + m * 16 + fr] * (1.0f / (float)(1 << (SCALE_LOG2 < 0 ? -SCALE_LOG2 : 0)));
                if (u.pn == 14) {
                    if (wc == 0 && fq == 0) { *(f32x4*)(fg + (size_t)row * 8) = acc[ai][0][m][0] * rs; *(f32x4*)(fg + (size_t)row * 8 + 4) = acc[ai][0][m][1] * rs; }
                } else {
                    const float sc = (u.pn < 2) ? rs * qscale : rs;
                    bf16_t* rowp = zb + (size_t)(u.pn >> 1) * arr_stride + (size_t)row * 512 + (u.pn & 1) * 256 + wc * 32 + 8 * fq;
#pragma unroll
                    for (int bj = 0; bj < 2; ++bj) { const f32x4 v0 = acc[ai][bj][m][0] * sc, v1 = acc[ai][bj][m][1] * sc;
                        u32x4 w; w.x = cvt_pk_bf16(v0[0], v0[1]); w.y = cvt_pk_bf16(v0[2], v0[3]); w.z = cvt_pk_bf16(v1[0], v1[1]); w.w = cvt_pk_bf16(v1[2], v1[3]);
                        *(u32x4*)(rowp + bj * HALF) = w; }
                }
            }
    }
};
typedef EpiInT<0> EpiIn;
struct EpiNull {
    static constexpr bool TOUCH = false, PERM = true, AFTER_DRAIN = false, HAS_PREP = false;
    static constexpr int NST = 0;
    __device__ __forceinline__ bool nst_ok(const Unit& u) const { return true; }
    float* sink; int never;
    __device__ __forceinline__ void operator()(const f32x4 (&acc)[2][2][4][2], const Unit& u, int wr, int wc, int fr, int fq, const PG8_LAS float* rtab) const {
        if (never) { f32x4 s = {0.f, 0.f, 0.f, 0.f};
#pragma unroll
            for (int a = 0; a < 2; ++a)
#pragma unroll
                for (int b = 0; b < 2; ++b)
#pragma unroll
                    for (int m = 0; m < 4; ++m) { s += acc[a][b][m][0]; s += acc[a][b][m][1]; }
            *(f32x4*)(sink + (size_t)(wr * 4 + wc) * 256 + (fq * 16 + fr) * 4) = s; }
    }
};
struct EpiPlain {
    static constexpr bool TOUCH = false, PERM = true, AFTER_DRAIN = false, HAS_PREP = false;
    static constexpr int NST = 16;
    __device__ __forceinline__ bool nst_ok(const Unit& u) const { return true; }
    bf16_t* O; int ldc; float scale;
    __device__ __forceinline__ void operator()(const f32x4 (&acc)[2][2][4][2], const Unit& u, int wr, int wc, int fr, int fq, const PG8_LAS float* rtab) const {
        const int row0 = u.pm * BM + wr * 64 + fr, col0 = u.pn * BM + wc * 32 + 8 * fq;
#pragma unroll
        for (int ai = 0; ai < 2; ++ai)
#pragma unroll
            for (int m = 0; m < 4; ++m) { bf16_t* rowp = O + (size_t)(row0 + ai * HALF + m * 16) * ldc + col0;
#pragma unroll
                for (int bj = 0; bj < 2; ++bj) { const f32x4 v0 = acc[ai][bj][m][0] * scale, v1 = acc[ai][bj][m][1] * scale;
                    u32x4 w; w.x = cvt_pk_bf16(v0[0], v0[1]); w.y = cvt_pk_bf16(v0[2], v0[3]); w.z = cvt_pk_bf16(v1[0], v1[1]); w.w = cvt_pk_bf16(v1[2], v1[3]);
                    *(u32x4*)(rowp + bj * HALF) = w; } }
    }
};
template <bool NORM> struct EpiSwi {
    static constexpr bool TOUCH = false, PERM = true, AFTER_DRAIN = false, HAS_PREP = NORM;
    static constexpr int NST = 8;
    __device__ __forceinline__ bool nst_ok(const Unit& u) const { return true; }
    bf16_t* O; int ldc; const float* ssq;
    __device__ __forceinline__ void prep(PG8_LAS float* tab, const Unit& u, int tid) const { prep_rstd(tab, ssq, u.pm, tid); }
    __device__ __forceinline__ void operator()(const f32x4 (&acc)[2][2][4][2], const Unit& u, int wr, int wc, int fr, int fq, const PG8_LAS float* rtab) const {
        const int row0 = u.pm * BM + wr * 64 + fr, col0 = u.pn * HALF + wc * 32 + 8 * fq;
#pragma unroll
        for (int ai = 0; ai < 2; ++ai)
#pragma unroll
            for (int m = 0; m < 4; ++m) { const int row = row0 + ai * HALF + m * 16; const float rs = NORM ? rtab[ai * HALF + wr * 64 + m * 16 + fr] : 1.0f;
                const float k1 = -1.4426950408889634f * rs, k2 = rs * rs;
                const f32x4 o0 = swiglu4(acc[ai][0][m][0], acc[ai][1][m][0], k1, k2), o1 = swiglu4(acc[ai][0][m][1], acc[ai][1][m][1], k1, k2);
                u32x4 w; w.x = cvt_pk_bf16(o0[0], o0[1]); w.y = cvt_pk_bf16(o0[2], o0[3]); w.z = cvt_pk_bf16(o1[0], o1[1]); w.w = cvt_pk_bf16(o1[2], o1[3]);
                *(u32x4*)(O + (size_t)row * ldc + col0) = w; }
    }
};
__device__ __forceinline__ float clamp448(float v) { return __builtin_fminf(__builtin_fmaxf(v, -448.f), 448.f); }
__device__ __forceinline__ unsigned pack4_fp8(float a, float b, float c, float d) {
    int w = __builtin_amdgcn_cvt_pk_fp8_f32(clamp448(a), clamp448(b), 0, false); w = __builtin_amdgcn_cvt_pk_fp8_f32(clamp448(c), clamp448(d), w, true); return (unsigned)w; }
template <bool NORM> struct EpiSwi8 {
    static constexpr bool TOUCH = false, PERM = true, AFTER_DRAIN = false, HAS_PREP = NORM;
    static constexpr int NST = 8;
    __device__ __forceinline__ bool nst_ok(const Unit& u) const { return true; }
    unsigned char* O; int ldc; float inv_in, out_scale; const float* ssq;
    __device__ __forceinline__ void prep(PG8_LAS float* tab, const Unit& u, int tid) const { prep_rstd(tab, ssq, u.pm, tid); }
    __device__ __forceinline__ void operator()(const f32x4 (&acc)[2][2][4][2], const Unit& u, int wr, int wc, int fr, int fq, const PG8_LAS float* rtab) const {
        const int row0 = u.pm * BM + wr * 64 + fr, col0 = u.pn * HALF + wc * 32 + 8 * fq;
#pragma unroll
        for (int ai = 0; ai < 2; ++ai)
#pragma unroll
            for (int m = 0; m < 4; ++m) { const int row = row0 + ai * HALF + m * 16; const float sc = NORM ? inv_in * rtab[ai * HALF + wr * 64 + m * 16 + fr] : inv_in;
                const float k1 = -1.4426950408889634f * sc, k2 = sc * sc * out_scale;
                const f32x4 o0 = swiglu4(acc[ai][0][m][0], acc[ai][1][m][0], k1, k2), o1 = swiglu4(acc[ai][0][m][1], acc[ai][1][m][1], k1, k2);
                u32x2 w; w.x = pack4_fp8(o0[0], o0[1], o0[2], o0[3]); w.y = pack4_fp8(o1[0], o1[1], o1[2], o1[3]);
                *(u32x2*)(O + (size_t)row * ldc + col0) = w; }
    }
};
template <int SCALE_LOG2 = 0, long H8_DELTA = 0, int H8_LOG2 = 0> struct EpiRes {
    static constexpr bool TOUCH = true, PERM = true, AFTER_DRAIN = false, HAS_PREP = false;
    static constexpr int NST = 0;
    __device__ __forceinline__ bool nst_ok(const Unit& u) const { return true; }
    bf16_t* hb; float* ssq_out;
    __device__ __forceinline__ void operator()(const f32x4 (&acc)[2][2][4][2], const Unit& u, int wr, int wc, int fr, int fq, const PG8_LAS float* rtab) const {
        const int row0 = u.pm * BM + wr * 64 + fr, col0 = u.pn * BM + wc * 32 + 8 * fq;
        constexpr float scale = SCALE_LOG2 >= 0 ? (float)(1 << (SCALE_LOG2 >= 0 ? SCALE_LOG2 : 0)) : 1.0f / (float)(1 << (SCALE_LOG2 < 0 ? -SCALE_LOG2 : 0));
#pragma unroll
        for (int ai = 0; ai < 2; ++ai) {
            u32x4 hv[4][2];
#pragma unroll
            for (int m = 0; m < 4; ++m)
#pragma unroll
                for (int bj = 0; bj < 2; ++bj) hv[m][bj] = *(const u32x4*)(hb + (size_t)(row0 + ai * HALF + m * 16) * 1024 + col0 + bj * HALF);
#pragma unroll
            for (int m = 0; m < 4; ++m) { const int row = row0 + ai * HALF + m * 16; const size_t off = (size_t)row * 1024 + col0; f32x4 s4 = {0.f, 0.f, 0.f, 0.f};
#pragma unroll
                for (int bj = 0; bj < 2; ++bj) { const size_t o2 = off + bj * HALF; u32x2 lo, hi; lo.x = hv[m][bj].x; lo.y = hv[m][bj].y; hi.x = hv[m][bj].z; hi.y = hv[m][bj].w;
                    const f32x4 o0 = SCALE_LOG2 == 0 ? bf4x(lo) + acc[ai][bj][m][0] : bf4x(lo) + acc[ai][bj][m][0] * scale, o1 = SCALE_LOG2 == 0 ? bf4x(hi) + acc[ai][bj][m][1] : bf4x(hi) + acc[ai][bj][m][1] * scale;
                    s4 += o0 * o0; s4 += o1 * o1;
                    u32x4 w; w.x = cvt_pk_bf16(o0[0], o0[1]); w.y = cvt_pk_bf16(o0[2], o0[3]); w.z = cvt_pk_bf16(o1[0], o1[1]); w.w = cvt_pk_bf16(o1[2], o1[3]); *(u32x4*)(hb + o2) = w;
                    if constexpr (H8_DELTA != 0) { constexpr float h8s = (float)(1 << H8_LOG2); u32x2 q; q.x = pack4_fp8(o0[0] * h8s, o0[1] * h8s, o0[2] * h8s, o0[3] * h8s); q.y = pack4_fp8(o1[0] * h8s, o1[1] * h8s, o1[2] * h8s, o1[3] * h8s);
                        *(u32x2*)((unsigned char*)hb + H8_DELTA + o2) = q; } }
                float s = (s4[0] + s4[1]) + (s4[2] + s4[3]); s = add_xor16(s); s = add_xor32(s);
                if (fq == 0) ssq_out[(size_t)(u.pn * 4 + wc) * SSQ_M + row] = s; }
            asm volatile("" ::: "memory"); }
    }
};
struct EpiP2 {
    static constexpr bool TOUCH = false, PERM = true, AFTER_DRAIN = false, HAS_PREP = false;
    static constexpr int NST = 0;
    __device__ __forceinline__ bool nst_ok(const Unit& u) const { return true; }
    bf16_t* P2;
    __device__ __forceinline__ void operator()(const f32x4 (&acc)[2][2][4][2], const Unit& u, int wr, int wc, int fr, int fq, const PG8_LAS float* rtab) const {
        const int row0 = u.pm * BM + wr * 64 + fr, col0 = u.pn * BM + wc * 32 + 8 * fq;
#pragma unroll
        for (int ai = 0; ai < 2; ++ai)
#pragma unroll
            for (int m = 0; m < 4; ++m) { const size_t off = (size_t)(row0 + ai * HALF + m * 16) * 1024 + col0;
#pragma unroll
                for (int bj = 0; bj < 2; ++bj) { const f32x4 o0 = acc[ai][bj][m][0], o1 = acc[ai][bj][m][1];
                    u32x4 w; w.x = cvt_pk_bf16(o0[0], o0[1]); w.y = cvt_pk_bf16(o0[2], o0[3]); w.z = cvt_pk_bf16(o1[0], o1[1]); w.w = cvt_pk_bf16(o1[2], o1[3]); *(u32x4*)(P2 + off + bj * HALF) = w; } }
    }
};
template <long H8_DELTA = 0, int H8_LOG2 = 0> struct EpiPleT {
    static constexpr bool TOUCH = true, PERM = true, AFTER_DRAIN = false, HAS_PREP = true;
    static constexpr int NST = 0;
    __device__ __forceinline__ bool nst_ok(const Unit& u) const { return true; }
    __device__ __forceinline__ void prep(PG8_LAS float* tab, const Unit& u, int tid) const { prep_rstd(tab, ssq_in, u.pm, tid); }
    const bf16_t* P2; bf16_t* hb; const float* ssq_in; float* ssq_out;
    __device__ __forceinline__ void operator()(const f32x4 (&acc)[2][2][4][2], const Unit& u, int wr, int wc, int fr, int fq, const PG8_LAS float* rtab) const {
        const int row0 = u.pm * BM + wr * 64 + fr, col0 = u.pn * BM + wc * 32 + 8 * fq;
#pragma unroll
        for (int ai = 0; ai < 2; ++ai) {
            u32x4 hv[4][2], pv[4][2];
#pragma unroll
            for (int m = 0; m < 4; ++m)
#pragma unroll
                for (int bj = 0; bj < 2; ++bj) { const size_t o2 = (size_t)(row0 + ai * HALF + m * 16) * 1024 + col0 + bj * HALF; hv[m][bj] = *(const u32x4*)(hb + o2); pv[m][bj] = *(const u32x4*)(P2 + o2); }
#pragma unroll
            for (int m = 0; m < 4; ++m) { const int row = row0 + ai * HALF + m * 16; const size_t off = (size_t)row * 1024 + col0; const float k1 = -1.4426950408889634f * rtab[ai * HALF + wr * 64 + m * 16 + fr]; f32x4 s4 = {0.f, 0.f, 0.f, 0.f};
#pragma unroll
                for (int bj = 0; bj < 2; ++bj) { const size_t o2 = off + bj * HALF; u32x4 w; unsigned q8[2] = {0u, 0u};
#pragma unroll
                    for (int n = 0; n < 2; ++n) { u32x2 hh, pp; hh.x = n ? hv[m][bj].z : hv[m][bj].x; hh.y = n ? hv[m][bj].w : hv[m][bj].y; pp.x = n ? pv[m][bj].z : pv[m][bj].x; pp.y = n ? pv[m][bj].w : pv[m][bj].y;
                        const f32x4 t = acc[ai][bj][m][n] * k1; f32x4 ex, r;
                        ex[0] = __builtin_amdgcn_exp2f(t[0]); ex[1] = __builtin_amdgcn_exp2f(t[1]); ex[2] = __builtin_amdgcn_exp2f(t[2]); ex[3] = __builtin_amdgcn_exp2f(t[3]);
                        const f32x4 d = ex + 1.0f;
                        r[0] = __builtin_amdgcn_rcpf(d[0]); r[1] = __builtin_amdgcn_rcpf(d[1]); r[2] = __builtin_amdgcn_rcpf(d[2]); r[3] = __builtin_amdgcn_rcpf(d[3]);
                        const f32x4 o = bf4x(hh) + bf4x(pp) * r;
                        s4 += o * o;
                        const unsigned c0 = cvt_pk_bf16(o[0], o[1]), c1 = cvt_pk_bf16(o[2], o[3]); if (n) { w.z = c0; w.w = c1; } else { w.x = c0; w.y = c1; }
                        if constexpr (H8_DELTA != 0) { const f32x4 o8 = o * (float)(1 << H8_LOG2); q8[n] = pack4_fp8(o8[0], o8[1], o8[2], o8[3]); } }
                    *(u32x4*)(hb + o2) = w;
                    if constexpr (H8_DELTA != 0) { u32x2 q; q.x = q8[0]; q.y = q8[1]; *(u32x2*)((unsigned char*)hb + H8_DELTA + o2) = q; } }
                float s = (s4[0] + s4[1]) + (s4[2] + s4[3]); s = add_xor16(s); s = add_xor32(s);
                if (fq == 0) ssq_out[(size_t)(u.pn * 4 + wc) * SSQ_M + row] = s; }
            asm volatile("" ::: "memory"); }
    }
};
typedef EpiPleT<0, 0> EpiPle;
struct MoeOrder {
    int nM, nN, nwg, G, c, nlim; int tpre[9]; int emask = 7;
    __device__ __forceinline__ void map(int L, Unit& u) const {
        int wgid = L; { const int q = nwg / NXCD, r = nwg % NXCD, xcd = wgid % NXCD, off = wgid / NXCD; wgid = (xcd < r ? xcd * (q + 1) : r * (q + 1) + (xcd - r) * q) + off; }
        const int nig = MK_MOE_WGM * nN, gid = wgid / nig, fm = gid * MK_MOE_WGM, gsz = (nM - fm) < MK_MOE_WGM ? (nM - fm) : MK_MOE_WGM;
        u.pm = fm + ((wgid % nig) % gsz); u.pn = (wgid % nig) / gsz;
        int e = 0;
#pragma unroll
        for (int k = 1; k < 8; ++k) e += (u.pm >= tpre[k]) ? 1 : 0;
        u.pb = (MK_PROBE == 21 ? (e & emask) : e) * nN + u.pn; u.koff = 0; u.tag = 0;
    }
    __device__ __forceinline__ bool next(int i, Unit& u) const { const long L = (long)i * G + c; if (L >= nlim) return false; map((int)L, u); return true; }
    __device__ __forceinline__ void a_ready(const Unit&) const {}
    __device__ __forceinline__ void done(const Unit&) const {}
};
struct LeftOrder {
    MoeOrder base; int L0, nleft, c, kq_len, split;
    __device__ __forceinline__ bool next(int i, Unit& u) const { if (i > 0 || c >= split * nleft) return false; const int j = c / split, kq = c - j * split; base.map(L0 + j, u); u.koff = kq * kq_len; u.tag = j * 8 + kq; return true; }
    __device__ __forceinline__ void a_ready(const Unit&) const {}
    __device__ __forceinline__ void done(const Unit&) const {}
};
__device__ __forceinline__ void moe_split_plan(int nwg, int G, int& L0, int& nleft) { L0 = (nwg / G) * G; nleft = nwg - L0; if (nleft * 4 > G || G != 256) { L0 = nwg; nleft = 0; } }
struct EpiPlainSplit {
    static constexpr bool TOUCH = false, PERM = true, AFTER_DRAIN = false, HAS_PREP = false;
    static constexpr int NST = 0;
    __device__ __forceinline__ bool nst_ok(const Unit& u) const { return true; }
    bf16_t* Y; bf16_t* YP; float scale; int np;
    __device__ __forceinline__ void operator()(const f32x4 (&acc)[2][2][4][2], const Unit& u, int wr, int wc, int fr, int fq, const PG8_LAS float* rtab) const {
        const int kq = u.tag & 7, j = u.tag >> 3; const int ldc = kq ? 256 : 1024;
        bf16_t* base = kq ? YP + (size_t)(j * np + kq - 1) * 65536 : Y + (size_t)u.pm * BM * 1024 + u.pn * BM;
        const int row0 = wr * 64 + fr, col0 = wc * 32 + 8 * fq;
#pragma unroll
        for (int ai = 0; ai < 2; ++ai)
#pragma unroll
            for (int m = 0; m < 4; ++m) { bf16_t* rowp = base + (size_t)(row0 + ai * HALF + m * 16) * ldc + col0;
#pragma unroll
                for (int bj = 0; bj < 2; ++bj) { const f32x4 v0 = acc[ai][bj][m][0] * scale, v1 = acc[ai][bj][m][1] * scale;
                    u32x4 w; w.x = cvt_pk_bf16(v0[0], v0[1]); w.y = cvt_pk_bf16(v0[2], v0[3]); w.z = cvt_pk_bf16(v1[0], v1[1]); w.w = cvt_pk_bf16(v1[2], v1[3]);
                    *(u32x4*)(rowp + bj * HALF) = w; } }
    }
};
}
#include <hip/hip_bf16.h>
#include <cmath>
namespace attn_body {
using bf16=__hip_bfloat16;
using bf16x8=__attribute__((ext_vector_type(8)))short;
using s16x4=__attribute__((ext_vector_type(4)))short;
using f32x16=__attribute__((ext_vector_type(16)))float;
using u32x4=__attribute__((ext_vector_type(4)))unsigned;
constexpr int BATCH=8,NHEAD=8,SEQ=2048,D=64,DM=512,MIXP=1024;
constexpr int NW=8,QBLK=32,QB=QBLK*NW,KVBLK=64,NQB=SEQ/QB;
constexpr int ATTN_PITCH=DM, ATTN_UNIT_ROWS=QB;
__device__ __forceinline__ int crow(int r,int hi){return (r&3)+8*(r>>2)+4*hi;}
#define SBAR() __builtin_amdgcn_sched_barrier(0)
__device__ __forceinline__ void cmask(f32x16&p0,f32x16&p1,int jb,int qrel,int hi){
  const float NEG=-INFINITY; int kb=64*jb+4*hi;
  #pragma unroll
  for(int r=0;r<16;++r){int kv=kb+(r&3)+8*(r>>2); if(kv>qrel)p0[r]=NEG; if(kv+32>qrel)p1[r]=NEG;}
}

constexpr int NSLOT=3, SLOTB=8192;
constexpr int LDS_K=0, LDS_V=NSLOT*SLOTB, LDS_WS=2*NSLOT*SLOTB, LDS_OST=LDS_WS+NW*64*4, LDS_BIAS=LDS_OST+NW*4096, LDS_BYTES=LDS_BIAS+SEQ*4;
constexpr float C2=0.125f*1.4426950408889634f;
__device__ __forceinline__ void glds16(const void*gsrc,unsigned lds_dst){unsigned keep;
  asm volatile("s_mov_b32 %0, m0\n\ts_mov_b32 m0, %2\n\ts_nop 0\n\tglobal_load_lds_dwordx4 %1, off\n\ts_mov_b32 m0, %0":"=&s"(keep):"v"(gsrc),"s"(lds_dst):"memory");}
__device__ __forceinline__ float max3f(float a,float b,float c){float r;asm("v_max3_f32 %0, %1, %2, %3":"=v"(r):"v"(a),"v"(b),"v"(c));return r;}
__device__ __forceinline__ float max2f(float a,float b){float r;asm("v_max_f32_e32 %0, %1, %2":"=v"(r):"v"(a),"v"(b));return r;}
__device__ __forceinline__ float fadd_s(float a,float b){float r;asm("v_add_f32_e32 %0, %1, %2":"=v"(r):"v"(a),"v"(b));return r;}
__device__ __forceinline__ float fsub_s(float a,float b){float r;asm("v_sub_f32_e32 %0, %1, %2":"=v"(r):"v"(a),"v"(b));return r;}
typedef float f32x2_t __attribute__((ext_vector_type(2))); typedef __bf16 bf16x2_t __attribute__((ext_vector_type(2)));
__device__ __forceinline__ unsigned cvtpk_s(float lo,float hi){f32x2_t v={lo,hi};bf16x2_t b=__builtin_convertvector(v,bf16x2_t);return __builtin_bit_cast(unsigned,b);}
#define WAIT_BAR(N) asm volatile("s_waitcnt vmcnt(" #N ") lgkmcnt(0)\n\ts_barrier":::"memory")

__device__ __forceinline__ void qkt(f32x16&p0,f32x16&p1,const char*Kslot,const bf16x8*qr,int r32,int hi){
  const char*kb=Kslot+hi*1024+r32*16;
  #pragma unroll
  for(int d0=0;d0<4;++d0){
    const bf16x8 b0=*reinterpret_cast<const bf16x8*>(kb+d0*2048);
    const bf16x8 b1=*reinterpret_cast<const bf16x8*>(kb+d0*2048+512);
    if(d0==0){p0=__builtin_amdgcn_mfma_f32_32x32x16_bf16(b0,qr[0],f32x16{},0,0,0);p1=__builtin_amdgcn_mfma_f32_32x32x16_bf16(b1,qr[0],f32x16{},0,0,0);}
    else{p0=__builtin_amdgcn_mfma_f32_32x32x16_bf16(b0,qr[d0],p0,0,0,0);p1=__builtin_amdgcn_mfma_f32_32x32x16_bf16(b1,qr[d0],p1,0,0,0);}}
}
typedef __attribute__((address_space(3))) const char* lds_cptr;
typedef short v4i16_t __attribute__((ext_vector_type(4)));
__device__ __forceinline__ void kload8(bf16x8*kf,lds_cptr kp){
  kf[0]=*(const __attribute__((address_space(3))) bf16x8*)(kp);      kf[1]=*(const __attribute__((address_space(3))) bf16x8*)(kp+512);
  kf[2]=*(const __attribute__((address_space(3))) bf16x8*)(kp+2048); kf[3]=*(const __attribute__((address_space(3))) bf16x8*)(kp+2560);
  kf[4]=*(const __attribute__((address_space(3))) bf16x8*)(kp+4096); kf[5]=*(const __attribute__((address_space(3))) bf16x8*)(kp+4608);
  kf[6]=*(const __attribute__((address_space(3))) bf16x8*)(kp+6144); kf[7]=*(const __attribute__((address_space(3))) bf16x8*)(kp+6656);
}
__device__ __forceinline__ void kload2(bf16x8*kf,lds_cptr kp,int j){ kf[2*j]=*(const __attribute__((address_space(3))) bf16x8*)(kp+j*2048); kf[2*j+1]=*(const __attribute__((address_space(3))) bf16x8*)(kp+j*2048+512); }
__device__ __forceinline__ s16x4 vtr(lds_cptr p){ return __builtin_bit_cast(s16x4,__builtin_amdgcn_ds_read_tr16_b64_v4i16((__attribute__((address_space(3))) v4i16_t*)p)); }
__device__ __forceinline__ float rowmax(const f32x16&p0,const f32x16&p1){
  float a=max3f(p0[0],p0[1],p1[0]),b=max3f(p0[2],p0[3],p1[1]);a=max3f(a,p1[2],p1[3]);
  #pragma unroll
  for(int r=4;r<16;r+=4){a=max3f(a,p0[r],p0[r+1]);b=max3f(b,p0[r+2],p0[r+3]);a=max3f(a,p1[r],p1[r+1]);b=max3f(b,p1[r+2],p1[r+3]);}
  const float m=max2f(a,b);
  auto rr=__builtin_amdgcn_permlane32_swap(__float_as_uint(m),__float_as_uint(m),false,false);
  return max2f(__uint_as_float(rr[0]),__uint_as_float(rr[1]));
}
__device__ __forceinline__ void pv(f32x16*o,int vb,bf16x8 pa0,bf16x8 pa1,bf16x8 pa2,bf16x8 pa3){
  #pragma unroll
  for(int d0=0;d0<2;++d0){s16x4 lo[4],hi[4];
    #pragma unroll
    for(int ks=0;ks<4;++ks){
      asm volatile("ds_read_b64_tr_b16 %0,%1 offset:%c2":"=&v"(lo[ks]):"v"(vb),"i"(d0*4096+ks*1024):"memory");
      asm volatile("ds_read_b64_tr_b16 %0,%1 offset:%c2":"=&v"(hi[ks]):"v"(vb),"i"(d0*4096+ks*1024+512):"memory");}
    asm volatile("s_waitcnt lgkmcnt(0)":::"memory");SBAR();
    #define PK(k) (bf16x8){lo[k][0],lo[k][1],lo[k][2],lo[k][3],hi[k][0],hi[k][1],hi[k][2],hi[k][3]}
    o[d0]=__builtin_amdgcn_mfma_f32_32x32x16_bf16(pa0,PK(0),o[d0],0,0,0);
    o[d0]=__builtin_amdgcn_mfma_f32_32x32x16_bf16(pa1,PK(1),o[d0],0,0,0);
    o[d0]=__builtin_amdgcn_mfma_f32_32x32x16_bf16(pa2,PK(2),o[d0],0,0,0);
    o[d0]=__builtin_amdgcn_mfma_f32_32x32x16_bf16(pa3,PK(3),o[d0],0,0,0);
    #undef PK
  }
}

#ifndef ATTN_STORE16
#define ATTN_STORE16(p,v) (*(u32x4*)(p)=(v))
#endif
typedef float f32x4_t __attribute__((ext_vector_type(4)));
template<int THRL> __device__ __forceinline__ void attn_unit(int b,int h,int qb,const bf16*Q,const bf16*__restrict__ K,const bf16*__restrict__ V,const float*__restrict__ cb,const float*__restrict__ gain,bf16*MIX,char*shm,int tid_in){
  const int tid=tid_in,lane=tid&63,r32=lane&31,hi=lane>>5; const int wid=__builtin_amdgcn_readfirstlane(tid>>6);
  const long rowbase=(long)b*SEQ; const int q0=qb*QB;
  const int NT_all=(q0+QB)/KVBLK; int t0;
  { const float cref0=cb[q0]; const bool cand=lane<NT_all-4; const float ce=cand?cb[64*lane+63]:cref0;
    const unsigned long long mk=__ballot(cand&&((cref0-ce)*1.4426950408889634f<-64.0f)); t0=__builtin_amdgcn_readfirstlane((int)__builtin_ctzll(~mk)&~1); }
  const bf16*Qw=Q+(rowbase+q0+wid*QBLK)*DM+h*D;
  const bf16*Kh=K+(rowbase+t0*KVBLK)*DM+h*D,*Vh=V+(rowbase+t0*KVBLK)*DM+h*D;
  const unsigned lds0=(unsigned)(uintptr_t)shm;
  float*wsf=(float*)(shm+LDS_WS)+wid*64;
  const bf16*ksrc=Kh+(long)lane*DM+wid*8;
  const bf16*vsrc=Vh+(long)(16*(wid&3)+(lane>>2))*DM+(wid>>2)*32+(lane&3)*8;
  const unsigned kdst=lds0+LDS_K+wid*1024, vdst=lds0+LDS_V+wid*1024;
  #define DMA_K(t,slot) glds16(ksrc+(long)(t)*KVBLK*DM,(unsigned)__builtin_amdgcn_readfirstlane(kdst+(slot)))
  #define DMA_V(t,slot) glds16(vsrc+(long)(t)*KVBLK*DM,(unsigned)__builtin_amdgcn_readfirstlane(vdst+(slot)))
  const int vb0=(int)(lds0+LDS_V)+((lane>>4)&1)*32+(lane&3)*8+(4*hi+((lane&15)>>2))*64;
  const char*Kbase=shm+LDS_K; bf16x8 kf[8];
  const lds_cptr shm3=(lds_cptr)shm; const lds_cptr kp0=shm3+LDS_K+hi*1024+r32*16; const lds_cptr vp0=shm3+LDS_V+((lane>>4)&1)*32+(lane&3)*8+(4*hi+((lane&15)>>2))*64;
  const int NT=NT_all-t0;
  const float cref=cb[q0]; const int bi4=tid*4; f32x4_t bv4=(f32x4_t){0.f,0.f,0.f,0.f}; if(bi4<NT*KVBLK)bv4=*(const f32x4_t*)(cb+t0*KVBLK+bi4);
  const float cqrow=cb[q0+wid*QBLK+r32];
  #define BIAS(P0,P1,t) do{ const __attribute__((address_space(3))) f32x4_t*bp_=(const __attribute__((address_space(3))) f32x4_t*)(shm3+LDS_BIAS)+(t)*16+hi; \
    _Pragma("unroll") for(int j_=0;j_<4;++j_){ const f32x4_t b0_=bp_[2*j_]-mhat,b1_=bp_[2*j_+8]-mhat; \
      P0[4*j_]+=b0_[0];P0[4*j_+1]+=b0_[1];P0[4*j_+2]+=b0_[2];P0[4*j_+3]+=b0_[3];P1[4*j_]+=b1_[0];P1[4*j_+1]+=b1_[1];P1[4*j_+2]+=b1_[2];P1[4*j_+3]+=b1_[3]; } }while(0)
  DMA_K(0,0);DMA_V(0,0);DMA_K(1,SLOTB);
  bf16x8 qr[4];
  #pragma unroll
  for(int d0=0;d0<4;++d0)qr[d0]=*reinterpret_cast<const bf16x8*>(&Qw[(long)r32*DM+d0*16+hi*8]);
  { float*bl=(float*)(shm+LDS_BIAS); if(bi4<NT*KVBLK)*(f32x4_t*)(bl+bi4)=(cref-bv4)*1.4426950408889634f; }
  float mhat=(cref-cqrow)*1.4426950408889634f,l_reg=0.f;f32x16 o[2];{float z0_=0.f;asm volatile("":"+v"(z0_));
    _Pragma("unroll") for(int r=0;r<16;++r){o[0][r]=z0_;o[1][r]=z0_;}}
  const int qrel=wid*QBLK+r32;
  #define CMASK(P0,P1,t) do{int jb_=(t)-(NT-4); if(jb_>=0)cmask(P0,P1,jb_,qrel,hi);}while(0)
  bool resc=false;
  #define START(P0,P1) do{ resc=false; \
    _Pragma("unroll") for(int r=0;r<16;++r)P0[r]=__builtin_amdgcn_exp2f(P0[r]); }while(0)
  #define RESC() do{ if(resc){ asm volatile("s_waitcnt lgkmcnt(0)":::"memory"); \
      _Pragma("unroll") for(int d_=0;d_<2;++d_) _Pragma("unroll") for(int r=0;r<16;++r)o[d_][r]*=wsf[crow(r,hi)]; } }while(0)
  f32x16 pA0,pA1,pB0,pB1;
  int sl_prev=0,sl_cur=0,sl_next=SLOTB;
  #define ROT() do{sl_prev=sl_cur;sl_cur=sl_next;sl_next=(sl_next==(NSLOT-1)*SLOTB)?0:sl_next+SLOTB;}while(0)
  DMA_K(2,2*SLOTB);
  WAIT_BAR(3);
  qkt(pA0,pA1,Kbase,qr,r32,hi);asm volatile("s_nop 15\n\ts_nop 7":"+v"(pA0),"+v"(pA1));BIAS(pA0,pA1,0);CMASK(pA0,pA1,0);
  START(pA0,pA1);
  _Pragma("unroll") for(int r=0;r<16;++r)pA1[r]=__builtin_amdgcn_exp2f(pA1[r]);
  WAIT_BAR(0);
  DMA_K(3,0);DMA_V(1,SLOTB);
  ROT();
  kload8(kf,kp0+sl_cur);
  WAIT_BAR(2);
  s16x4 vlo[8],vhi[8]; u32x4 pw0,pw1,pw2,pw3;
  #define PKW(P,B) cvtpk_s(P[B],P[B+1])
  #define PAF(k) __builtin_bit_cast(bf16x8,pw##k)
  #define VFR(i) (bf16x8){vlo[i][0],vlo[i][1],vlo[i][2],vlo[i][3],vhi[i][0],vhi[i][1],vhi[i][2],vhi[i][3]}
  #define PIN(x) asm volatile("":"+v"(x))
  #define MX3(a,b,c) __builtin_fmaxf(__builtin_fmaxf((a),(b)),(c))
  #define GAPA(MF,A0,A1,A2,A3,W0,W1,PW) do{ MF; sacc+=A0; sacc+=A1; sacc+=A2; sacc+=A3; PIN(sacc); W0; W1; PIN(PW); SBAR(); }while(0)
  #define EX(v) __builtin_amdgcn_exp2f(v)
  #define GAPB(MF,X,B) do{ MF; X[B]=EX(X[B]); X[B+1]=EX(X[B+1]); X[B+2]=EX(X[B+2]); X[B+3]=EX(X[B+3]); PIN(X); SBAR(); }while(0)
  #define VRD(i) do{ vlo[i]=vtr(vp_+(((i)>>2)*4096+((i)&3)*1024)); vhi[i]=vtr(vp_+(((i)>>2)*4096+((i)&3)*1024+512)); }while(0)
  #define KRD(G,j) do{ if(G){ kload2(kf,kp0+sl_next,j); SBAR(); } }while(0)
  #define STEP(C0,C1,P0,P1,t,GK,GV,GL) do{ SBAR(); \
    const lds_cptr vp_=vp0+sl_prev; \
    VRD(0); SBAR(); float sacc=(P0[0]+P0[1]); \
    GAPA(C0=__builtin_amdgcn_mfma_f32_32x32x16_bf16(kf[0],qr[0],f32x16{},0,0,0), P0[2],P0[3],P0[4],P0[5],     pw0[0]=PKW(P0,0), pw0[1]=PKW(P0,2), pw0); \
    VRD(4); SBAR(); GAPA(C1=__builtin_amdgcn_mfma_f32_32x32x16_bf16(kf[1],qr[0],f32x16{},0,0,0), P0[6],P0[7],P0[8],P0[9],     pw0[2]=PKW(P0,4), pw0[3]=PKW(P0,6), pw0); \
    VRD(1); SBAR(); GAPA(C0=__builtin_amdgcn_mfma_f32_32x32x16_bf16(kf[2],qr[1],C0,0,0,0),   P0[10],P0[11],P0[12],P0[13], pw1[0]=PKW(P0,8), pw1[1]=PKW(P0,10), pw1); \
    VRD(5); SBAR(); GAPA(C1=__builtin_amdgcn_mfma_f32_32x32x16_bf16(kf[3],qr[1],C1,0,0,0),   P0[14],P0[15],P1[0],P1[1],   pw1[2]=PKW(P0,12),pw1[3]=PKW(P0,14), pw1); \
    VRD(2); SBAR(); GAPA(C0=__builtin_amdgcn_mfma_f32_32x32x16_bf16(kf[4],qr[2],C0,0,0,0),   P1[2],P1[3],P1[4],P1[5],     pw2[0]=PKW(P1,0), pw2[1]=PKW(P1,2), pw2); \
    VRD(6); SBAR(); GAPA(C1=__builtin_amdgcn_mfma_f32_32x32x16_bf16(kf[5],qr[2],C1,0,0,0),   P1[6],P1[7],P1[8],P1[9],     pw2[2]=PKW(P1,4), pw2[3]=PKW(P1,6), pw2); \
    VRD(3); SBAR(); GAPA(C0=__builtin_amdgcn_mfma_f32_32x32x16_bf16(kf[6],qr[3],C0,0,0,0),   P1[10],P1[11],P1[12],P1[13], pw3[0]=PKW(P1,8), pw3[1]=PKW(P1,10), pw3); \
    VRD(7); SBAR(); GAPA(C1=__builtin_amdgcn_mfma_f32_32x32x16_bf16(kf[7],qr[3],C1,0,0,0),   P1[14],P1[15],0.f,0.f,       pw3[2]=PKW(P1,12),pw3[3]=PKW(P1,14), pw3); \
    l_reg+=sacc; \
    if(GK){DMA_K((t)+3,sl_cur);} if(GV){DMA_V((t)+1,sl_next);} \
    BIAS(C0,C1,t); CMASK(C0,C1,t); \
    { float a=MX3(C0[0],C0[1],C1[0]),b=MX3(C0[2],C0[3],C1[1]); a=MX3(a,C1[2],C1[3]); \
      _Pragma("unroll") for(int r=4;r<16;r+=4){a=MX3(a,C0[r],C0[r+1]);b=MX3(b,C0[r+2],C0[r+3]);a=MX3(a,C1[r],C1[r+1]);b=MX3(b,C1[r+2],C1[r+3]);} \
      float rm=__builtin_fmaxf(a,b); { auto rr=__builtin_amdgcn_permlane32_swap(__float_as_uint(rm),__float_as_uint(rm),false,false); rm=__builtin_fmaxf(__uint_as_float(rr[0]),__uint_as_float(rr[1])); } \
      resc=false; \
      if(__builtin_expect(__any(rm>(float)THRL),0)){ const float dl=__builtin_fmaxf(rm,0.f); mhat+=dl; \
        _Pragma("unroll") for(int r=0;r<16;++r){C0[r]-=dl;C1[r]-=dl;} \
        const float f=__builtin_amdgcn_exp2f(-dl); l_reg*=f; if(hi==0)wsf[r32]=f; resc=true; } } \
    SBAR(); \
    GAPB(o[0]=__builtin_amdgcn_mfma_f32_32x32x16_bf16(PAF(0),VFR(0),o[0],0,0,0), C0,0); \
    GAPB(o[1]=__builtin_amdgcn_mfma_f32_32x32x16_bf16(PAF(0),VFR(4),o[1],0,0,0), C0,4); \
    KRD(GL,0); GAPB(o[0]=__builtin_amdgcn_mfma_f32_32x32x16_bf16(PAF(1),VFR(1),o[0],0,0,0), C0,8); \
    KRD(GL,1); GAPB(o[1]=__builtin_amdgcn_mfma_f32_32x32x16_bf16(PAF(1),VFR(5),o[1],0,0,0), C0,12); \
    KRD(GL,2); GAPB(o[0]=__builtin_amdgcn_mfma_f32_32x32x16_bf16(PAF(2),VFR(2),o[0],0,0,0), C1,0); \
    KRD(GL,3); GAPB(o[1]=__builtin_amdgcn_mfma_f32_32x32x16_bf16(PAF(2),VFR(6),o[1],0,0,0), C1,4); \
    GAPB(o[0]=__builtin_amdgcn_mfma_f32_32x32x16_bf16(PAF(3),VFR(3),o[0],0,0,0), C1,8); \
    GAPB(o[1]=__builtin_amdgcn_mfma_f32_32x32x16_bf16(PAF(3),VFR(7),o[1],0,0,0), C1,12); \
    }while(0)
  int t=1;
  #undef CMASK
  #define CMASK(P0,P1,t) do{}while(0)
  for(;t+5<NT;t+=2){
    STEP(pB0,pB1,pA0,pA1,t,true,true,true);     WAIT_BAR(2); RESC(); ROT();
    STEP(pA0,pA1,pB0,pB1,t+1,true,true,true);   WAIT_BAR(2); RESC(); ROT();
  }
  #undef CMASK
  #define CMASK(P0,P1,t) do{int jb_=(t)-(NT-4); if(jb_>=0)cmask(P0,P1,jb_,qrel,hi);}while(0)
  #define ENDW(tt) do{ if((tt)+3<NT){WAIT_BAR(2);} else if((tt)+2<NT){WAIT_BAR(1);} else {WAIT_BAR(0);} }while(0)
  for(;t+1<NT;t+=2){
    STEP(pB0,pB1,pA0,pA1,t,(t+3<NT),(t+1<NT),(t+1<NT));       ENDW(t);   RESC(); ROT();
    STEP(pA0,pA1,pB0,pB1,t+1,(t+4<NT),(t+2<NT),(t+2<NT));     ENDW(t+1); RESC(); ROT();
  }
  STEP(pB0,pB1,pA0,pA1,NT-1,false,false,false); RESC();
  { float sacc=pB0[0]+pB0[1]; _Pragma("unroll") for(int r=2;r<16;++r)sacc+=pB0[r]; _Pragma("unroll") for(int r=0;r<16;++r)sacc+=pB1[r]; l_reg+=sacc;
    pw0=(u32x4){PKW(pB0,0),PKW(pB0,2),PKW(pB0,4),PKW(pB0,6)};pw1=(u32x4){PKW(pB0,8),PKW(pB0,10),PKW(pB0,12),PKW(pB0,14)};pw2=(u32x4){PKW(pB1,0),PKW(pB1,2),PKW(pB1,4),PKW(pB1,6)};pw3=(u32x4){PKW(pB1,8),PKW(pB1,10),PKW(pB1,12),PKW(pB1,14)};
    SBAR(); pv(o,vb0+sl_cur,PAF(0),PAF(1),PAF(2),PAF(3)); }
  #undef PKW
  #undef PAF
  #undef VFR
  #undef PIN
  #undef MX3
  #undef GAPA
  #undef GAPB
  #undef EX
  #undef VRD
  #undef KRD
  #undef STEP
  #undef ENDW
  {auto rr=__builtin_amdgcn_permlane32_swap(__float_as_uint(l_reg),__float_as_uint(l_reg),false,false);l_reg=__uint_as_float(rr[0])+__uint_as_float(rr[1]);}
  if(hi==0)wsf[32+r32]=l_reg;asm volatile("s_waitcnt lgkmcnt(0)":::"memory");
  float rli[16];
  #pragma unroll
  for(int r=0;r<16;++r)rli[r]=__builtin_amdgcn_rcpf(wsf[32+crow(r,hi)]);
  bf16*Ow=MIX+(rowbase+q0+wid*QBLK)*MIXP+h*D;
  { bf16*stg=(bf16*)(shm+LDS_OST)+wid*2048;
    #pragma unroll
    for(int r=0;r<16;++r){const int orow=crow(r,hi);
      #pragma unroll
      for(int d0=0;d0<2;++d0)stg[orow*64+d0*32+r32]=__float2bfloat16(o[d0][r]*rli[r]);}
    asm volatile("s_waitcnt lgkmcnt(0)":::"memory");
    const int ch=lane&7; const f32x4_t g0=*(const f32x4_t*)(gain+h*D+ch*8),g1=*(const f32x4_t*)(gain+h*D+ch*8+4);
    #pragma unroll
    for(int i=0;i<4;++i){const int row=i*8+(lane>>3); const u32x4 v=*(const u32x4*)(stg+row*64+ch*8);
      const float f0=__uint_as_float(v.x<<16),f1=__uint_as_float(v.x&0xffff0000u),f2=__uint_as_float(v.y<<16),f3=__uint_as_float(v.y&0xffff0000u),f4=__uint_as_float(v.z<<16),f5=__uint_as_float(v.z&0xffff0000u),f6=__uint_as_float(v.w<<16),f7=__uint_as_float(v.w&0xffff0000u);
      float ss=((f0*f0+f1*f1)+(f2*f2+f3*f3))+((f4*f4+f5*f5)+(f6*f6+f7*f7)); ss=pg8::add_xor1(ss); ss=pg8::add_xor2(ss); ss=pg8::add_xor4(ss);
      const float rs=rsqrtf(ss*(1.0f/64.0f)+1e-6f);
      u32x4 w; w.x=cvtpk_s(f0*rs*g0[0],f1*rs*g0[1]); w.y=cvtpk_s(f2*rs*g0[2],f3*rs*g0[3]); w.z=cvtpk_s(f4*rs*g1[0],f5*rs*g1[1]); w.w=cvtpk_s(f6*rs*g1[2],f7*rs*g1[3]);
      ATTN_STORE16(Ow+(long)row*MIXP+ch*8,w);} }
  asm volatile("s_waitcnt lgkmcnt(0)\n\ts_barrier":::"memory");
  #undef BIAS
  #undef DMA_K
  #undef DMA_V
  #undef CMASK
  #undef START
  #undef RESC
  #undef ROT
}
constexpr int ATTN_LDS_BYTES=LDS_BYTES;
struct AttnTensors { const bf16* Q; const bf16* K; const bf16* V; const float* C; const float* gain; bf16* MIX; };
struct AttnUnit { int bh; int qb; };
struct StaticOrder {
  int vcu,G;
  __device__ __forceinline__ explicit StaticOrder(int grid,int block):vcu((grid%8==0)?(block%8)*(grid/8)+block/8:block),G(grid){}
  __device__ __forceinline__ bool next(int i,AttnUnit&u)const{ const int pair=vcu+(i>>1)*G; if(pair>=BATCH*NHEAD*4)return false; const int s=pair&3; u.bh=pair>>2; u.qb=(i&1)?s:7-s; return true; }
  __device__ __forceinline__ void a_ready(const AttnUnit&)const{}
  __device__ __forceinline__ void done(const AttnUnit&)const{}
};
template<class Sched,int THRL=8> __device__ __forceinline__ void attn_phase(char*lds,const AttnTensors&T,const Sched&S,int tid_in){
  AttnUnit u;
  for(int i=0;S.next(i,u);++i){ S.a_ready(u); attn_unit<THRL>(u.bh/NHEAD,u.bh%NHEAD,u.qb,T.Q,T.K,T.V,T.C+(long)u.bh*SEQ,T.gain,T.MIX,lds,tid_in); S.done(u); }
}
#undef SBAR
#undef WAIT_BAR
}
#define GAS __attribute__((address_space(1)))
#define LAS __attribute__((address_space(3)))
typedef unsigned short bf16;
typedef unsigned v4u __attribute__((ext_vector_type(4)));
typedef float f32x4 __attribute__((ext_vector_type(4)));
typedef short bf16x8 __attribute__((ext_vector_type(8)));
typedef GAS unsigned gu32;
typedef GAS unsigned long long gu64;
#define RLX_AGENT __ATOMIC_RELAXED, __HIP_MEMORY_SCOPE_AGENT
#define LDS_WAIT() asm volatile("s_waitcnt lgkmcnt(0)" ::: "memory")
#define VM_WAIT() asm volatile("s_waitcnt vmcnt(0)" ::: "memory")
__device__ __forceinline__ unsigned long long rt() { return __builtin_amdgcn_s_memrealtime(); }
__device__ __forceinline__ unsigned f2bf(float f) { unsigned u = __builtin_bit_cast(unsigned, f); return (u + 0x7fffu + ((u >> 16) & 1u)) >> 16; }
__device__ __forceinline__ unsigned pk2(float lo, float hi) { return f2bf(lo) | (f2bf(hi) << 16); }

#define XB_TMO      128
#define XB_XCNT(j)  (256  + 64 * (j))
#define XB_XSUB(j)  (1280 + 64 * (j))
#define XB_XGEN(j)  (2304 + 64 * (j))
#define XB_TOP      3328
#define XB_TOPGEN   3392
#define XCD_BAR_WORDS 3456
#define XB_SPIN_CAP (1u << 18)

__device__ __forceinline__ unsigned xb_ld(unsigned* p)              { return __hip_atomic_load(p, __ATOMIC_RELAXED, __HIP_MEMORY_SCOPE_AGENT); }
__device__ __forceinline__ unsigned xb_add(unsigned* p, unsigned v) { return __hip_atomic_fetch_add(p, v, __ATOMIC_RELAXED, __HIP_MEMORY_SCOPE_AGENT); }
__device__ __forceinline__ unsigned xb_xcc_id() { return (unsigned)__builtin_amdgcn_s_getreg((3 << 11) | 20) & 0xFu; }
#define XB_SPIN(cond, bar) do { unsigned _sp = 0; while (cond) { __builtin_amdgcn_s_sleep(1); \
    if ((++_sp & 255u) == 0u) { if (xb_ld(&(bar)[XB_TMO])) break; if (_sp > XB_SPIN_CAP) { atomicAdd(&(bar)[XB_TMO], 1u); break; } } } } while (0)

struct XcdBarrier {
    unsigned* bar; unsigned x;
    volatile LAS unsigned* st;
};

__device__ __forceinline__ int lane_id_volatile() { int l; asm volatile("v_mbcnt_lo_u32_b32 %0, -1, 0\n\tv_mbcnt_hi_u32_b32 %0, -1, %0" : "=v"(l)); return l; }
__device__ __forceinline__ bool xb_t0(int wave) { return wave == 0 && lane_id_volatile() == 0; }
__device__ __forceinline__ XcdBarrier xcd_barrier_post(unsigned* bar, volatile LAS unsigned* st, int wave) {
    XcdBarrier b; b.bar = bar; b.x = xb_xcc_id(); b.st = st;
    if (xb_t0(wave)) (void)xb_add(&bar[XB_XCNT(b.x)], 1u);
    return b;
}
__device__ __forceinline__ void xcd_barrier_complete(unsigned* bar, unsigned x, unsigned& nloc, unsigned& nx) {
    const unsigned G = gridDim.x * gridDim.y * gridDim.z;
    unsigned sum, cnt, mine, sp = 0u;
    for (;;) {
        sum = 0u; cnt = 0u; mine = 0u;
#pragma unroll
        for (unsigned j = 0; j < 16; ++j) { const unsigned c = xb_ld(&bar[XB_XCNT(j)]); sum += c; cnt += (c > 0u) ? 1u : 0u; mine = (j == x) ? c : mine; }
        if (sum == G) break;
        __builtin_amdgcn_s_sleep(1);
        if ((++sp & 255u) == 0u) { if (xb_ld(&bar[XB_TMO])) break; if (sp > XB_SPIN_CAP) { atomicAdd(&bar[XB_TMO], 1u); break; } }
    }
    nloc = mine > 0u ? mine : 1u; nx = cnt > 0u ? cnt : 1u;
}

__device__ __forceinline__ void xcd_barrier(const XcdBarrier& b, int wave) {
    asm volatile("s_waitcnt vmcnt(0)" ::: "memory");
    __syncthreads();
    if (xb_t0(wave)) {
        unsigned* bar = b.bar;
        __builtin_amdgcn_s_waitcnt(0);
        unsigned nloc = b.st[0], nx = b.st[1];
        if (nloc == 0u) { xcd_barrier_complete(bar, b.x, nloc, nx); b.st[0] = nloc; b.st[1] = nx; }
        const unsigned old = xb_add(&bar[XB_XSUB(b.x)], 1u);
        const unsigned gen = old / nloc;
        if (old + 1u == (gen + 1u) * nloc) {
            __builtin_amdgcn_fence(__ATOMIC_RELEASE, "agent");
            asm volatile("s_waitcnt vmcnt(0)" ::: "memory");
            const unsigned og = xb_add(&bar[XB_TOP], 1u);
            const unsigned tg = og / nx;
            if (og + 1u == (tg + 1u) * nx) xb_add(&bar[XB_TOPGEN], 1u);
            else XB_SPIN(xb_ld(&bar[XB_TOPGEN]) == tg, bar);
            __builtin_amdgcn_fence(__ATOMIC_ACQUIRE, "agent");
            xb_add(&bar[XB_XGEN(b.x)], 1u);
            asm volatile("s_waitcnt vmcnt(0)" ::: "memory");
        } else {
            XB_SPIN(xb_ld(&bar[XB_XGEN(b.x)]) == gen, bar);
            __builtin_amdgcn_fence(__ATOMIC_ACQUIRE, "agent");
            asm volatile("s_waitcnt vmcnt(0)" ::: "memory");
        }
    }
    __syncthreads();
}
template <class Idle> __device__ __forceinline__ void xcd_barrier_idle(const XcdBarrier& b, int wave, Idle idle) {
    asm volatile("s_waitcnt vmcnt(0)" ::: "memory");
    __syncthreads();
    if (xb_t0(wave)) {
        unsigned* bar = b.bar;
        __builtin_amdgcn_s_waitcnt(0);
        unsigned nloc = b.st[0], nx = b.st[1];
        if (nloc == 0u) { xcd_barrier_complete(bar, b.x, nloc, nx); b.st[0] = nloc; b.st[1] = nx; }
        const unsigned old = xb_add(&bar[XB_XSUB(b.x)], 1u);
        const unsigned gen = old / nloc;
        if (old + 1u == (gen + 1u) * nloc) {
            __builtin_amdgcn_fence(__ATOMIC_RELEASE, "agent");
            asm volatile("s_waitcnt vmcnt(0)" ::: "memory");
            const unsigned og = xb_add(&bar[XB_TOP], 1u);
            const unsigned tg = og / nx;
            if (og + 1u == (tg + 1u) * nx) xb_add(&bar[XB_TOPGEN], 1u);
            else XB_SPIN(xb_ld(&bar[XB_TOPGEN]) == tg, bar);
            __builtin_amdgcn_fence(__ATOMIC_ACQUIRE, "agent");
            xb_add(&bar[XB_XGEN(b.x)], 1u);
            asm volatile("s_waitcnt vmcnt(0)" ::: "memory");
        } else {
            XB_SPIN(xb_ld(&bar[XB_XGEN(b.x)]) == gen, bar);
            __builtin_amdgcn_fence(__ATOMIC_ACQUIRE, "agent");
            asm volatile("s_waitcnt vmcnt(0)" ::: "memory");
        }
    } else if (wave != 0) idle();
    __syncthreads();
}
constexpr int NWAVES = 8;
constexpr int BATCH = 8, SEQ = 2048, M = BATCH * SEQ, D = 1024, DEPTH = 4, DPLE = 256, HD = 64, NHEAD = 8;
constexpr int DIN = 3592, NIN = 3840  , DFF = 2816, NE = 8, DEXP = 3584;
constexpr int SLOTS = 2 * M + NE * 256;
constexpr float C2 = 0.125f * 1.4426950408889634f;
constexpr float LN2 = 0.6931471805599453f;
constexpr float F8_SX = 4.f, F8_SWU = 64.f, F8_SH = 8.f, F8_SWD = 128.f;
static_assert(F8_SX == 4.f && F8_SH * F8_SWD == 1024.f, "EpiRes template exponents in the step program assume these");


constexpr size_t MiB = 1u << 20;
constexpr size_t WS_CTL = 0, CTL_ZERO_BYTES = 1 * MiB;
constexpr size_t WS_WIN = 1 * MiB;
constexpr size_t WS_WOUT = WS_WIN + 4 * (size_t)NIN * D * 2;
constexpr size_t WS_WPLE = WS_WOUT + 4 * (size_t)D * D * 2;
constexpr size_t WS_WPG = WS_WPLE + 4 * (size_t)D * DPLE * 2;
constexpr size_t WS_WGU = WS_WPG + 4 * (size_t)D * D * 2;
constexpr size_t WS_WD = WS_WGU + 2 * (size_t)2 * DFF * D * 2;
constexpr size_t WS_WEGU = WS_WD + 2 * (size_t)D * DFF * 2;
constexpr size_t WS_WED = WS_WEGU + 2 * (size_t)NE * 2 * DEXP * D * 2;
constexpr size_t WS_WR = WS_WED + 2 * (size_t)NE * D * DEXP * 2;
constexpr size_t WS_LB = WS_WR + 2 * (size_t)NE * D * 4;
constexpr size_t WS_META = WS_LB + 4 * 512 * 4;
constexpr size_t WS_H = ((WS_META + 256 + MiB - 1) / MiB) * MiB;
constexpr size_t WS_H8 = WS_H;
constexpr size_t WS_HB = WS_H + (size_t)M * D * 4;
constexpr size_t WS_SSQ = WS_HB + (size_t)M * D * 2;
constexpr size_t WS_PB = WS_SSQ + 2 * (size_t)M * 16 * 4;
constexpr size_t WS_P2 = WS_PB + (size_t)DEPTH * M * DPLE * 2;
constexpr size_t WS_TOKE = WS_P2 + (size_t)M * D * 2;
constexpr size_t WS_TOKW = WS_TOKE + (size_t)M * 8;
constexpr size_t WS_RANK = WS_TOKW + (size_t)M * 8;
constexpr size_t WS_SLOT = WS_RANK + (size_t)M * 8;
constexpr size_t WS_RSTD = WS_SLOT + (size_t)M * 8;
constexpr size_t WS_BCNT = WS_RSTD + (size_t)M * 4;
constexpr size_t WS_PLOG = ((WS_BCNT + 8192 + MiB - 1) / MiB) * MiB;
constexpr size_t WS_SCR = WS_PLOG + (size_t)M * 16 * 8 * 4;
constexpr size_t WS_ZB = WS_SCR;
constexpr size_t ZARR = (size_t)M * 512;
constexpr size_t WS_FG = WS_ZB + 7 * ZARR * 2;
constexpr size_t WS_CB = WS_FG + (size_t)M * 8 * 4;
constexpr size_t WS_MIX = WS_CB + (size_t)M * 8 * 4;
constexpr size_t WS_HL = WS_MIX + (size_t)M * D * 2;
constexpr size_t WS_HS = WS_HL + (size_t)2048 * 4096 * 4;
constexpr size_t WS_HG_ = WS_HS + (size_t)2048 * 4096 * 4;
constexpr size_t WS_MIX_END = WS_HG_ + (size_t)2048 * 64 * 4;
constexpr size_t WS_ACT = WS_SCR;
constexpr size_t WS_XG = WS_SCR;
constexpr size_t WS_HGB = WS_XG + (size_t)SLOTS * D * 2;
constexpr size_t WS_YP = WS_HGB + (size_t)SLOTS * DEXP * 2;
constexpr size_t YP_TILES = 256;
constexpr size_t WS_END = (WS_YP + YP_TILES * 65536 * 2 > WS_MIX_END) ? WS_YP + YP_TILES * 65536 * 2 : WS_MIX_END;
constexpr int CW_BAR = 4096, MAX_BAR_REGIONS = 64;
static_assert((CW_BAR + MAX_BAR_REGIONS * 3456) * 4 <= (int)CTL_ZERO_BYTES, "ctl");

constexpr int RING_OFF = 0, RING_BYTES = 131072;
constexpr int LDSCTL_OFF = RING_BYTES, MISC_OFF = LDSCTL_OFF + 320;
constexpr int LDS_BYTES = 147456;

struct Args { const float* in[21]; float* out; unsigned char* ws; int s_lo, s_hi, li, pad; };
typedef const __attribute__((address_space(4))) Args KArgs;
#define KIN(F, k) ((const float*)(const GAS float*)(F).ka->in[k])
struct Frame {
    LAS unsigned char* lds; volatile LAS unsigned* MISC;
    int tid, lane, wave, G, gw, NGW, bx;
    const KArgs* ka; float* out; GAS unsigned char* ws;
};
template <int CTRL, int ROWM> __device__ __forceinline__ float dpp0(float v) { return __builtin_bit_cast(float, __builtin_amdgcn_update_dpp(0, __builtin_bit_cast(int, v), CTRL, ROWM, 0xf, true)); }
__device__ __forceinline__ float wave_incl_scan(float v) {
    v += dpp0<0x111, 0xf>(v); v += dpp0<0x112, 0xf>(v); v += dpp0<0x114, 0xf>(v); v += dpp0<0x118, 0xf>(v);
    v += dpp0<0x142, 0xa>(v);
    v += dpp0<0x143, 0xc>(v);
    return v;
}
__device__ __forceinline__ void wave_incl_scan4(float& a, float& b, float& c, float& d) {
#define WS4_STEP(CTRL, ROWM) { const float ta = dpp0<CTRL, ROWM>(a), tb = dpp0<CTRL, ROWM>(b), tc = dpp0<CTRL, ROWM>(c), td = dpp0<CTRL, ROWM>(d); a += ta; b += tb; c += tc; d += td; }
    WS4_STEP(0x111, 0xf) WS4_STEP(0x112, 0xf) WS4_STEP(0x114, 0xf) WS4_STEP(0x118, 0xf) WS4_STEP(0x142, 0xa) WS4_STEP(0x143, 0xc)
#undef WS4_STEP
}
__device__ __forceinline__ float wave_sum(float v) { return __builtin_bit_cast(float, __builtin_amdgcn_readlane(__builtin_bit_cast(int, wave_incl_scan(v)), 63)); }
__device__ __forceinline__ f32x4 ldh4(const bf16* p) { const unsigned long long a = *(const unsigned long long*)p; f32x4 r; r[0] = __uint_as_float((unsigned)a << 16); r[1] = __uint_as_float((unsigned)a & 0xffff0000u); r[2] = __uint_as_float((unsigned)(a >> 32) << 16); r[3] = __uint_as_float((unsigned)(a >> 32) & 0xffff0000u); return r; }
__device__ __forceinline__ f32x4 ldh4nt(const bf16* p) { const unsigned long long a = __builtin_nontemporal_load((const unsigned long long*)p); f32x4 r; r[0] = __uint_as_float((unsigned)a << 16); r[1] = __uint_as_float((unsigned)a & 0xffff0000u); r[2] = __uint_as_float((unsigned)(a >> 32) << 16); r[3] = __uint_as_float((unsigned)(a >> 32) & 0xffff0000u); return r; }
__device__ __forceinline__ float log_sigmoid_f(float x) { return fminf(x, 0.f) - 0.6931471805599453f * __builtin_amdgcn_logf(1.f + __builtin_amdgcn_exp2f(-1.4426950408889634f * fabsf(x))); }

__device__ __forceinline__ void tr_item(const float* src, int ld, const float* gain, bf16* dst, int dK, LAS float* scr, int lane) {
    float vr[32];
    { const float* p = src + (size_t)(lane >> 5) * ld + (lane & 31); const size_t st = (size_t)2 * ld;
#pragma unroll
      for (int i = 0; i < 32; ++i) { vr[i] = MK_NT ? __builtin_nontemporal_load(p) : *p; p += st; } }
    if (gain) { const float* gp = gain + (lane >> 5);
#pragma unroll
        for (int i = 0; i < 32; ++i) vr[i] *= gp[2 * i]; }
#pragma unroll
    for (int i = 0; i < 32; ++i) scr[(2 * i + (lane >> 5)) * 33 + (lane & 31)] = vr[i];
    LDS_WAIT(); asm volatile("" ::: "memory");
    const int c = lane & 7;
#pragma unroll
    for (int j = 0; j < 4; ++j) { const int n = (lane >> 3) + 8 * j; const LAS float* s = scr + (8 * c) * 33 + n;
        v4u o; o.x = pg8::cvt_pk_bf16(s[0 * 33], s[1 * 33]); o.y = pg8::cvt_pk_bf16(s[2 * 33], s[3 * 33]); o.z = pg8::cvt_pk_bf16(s[4 * 33], s[5 * 33]); o.w = pg8::cvt_pk_bf16(s[6 * 33], s[7 * 33]);
        if (MK_NT) __builtin_nontemporal_store(o, (GAS v4u*)(dst + (size_t)n * dK + 8 * c)); else *(GAS v4u*)(dst + (size_t)n * dK + 8 * c) = o; }
    LDS_WAIT(); asm volatile("" ::: "memory");
}
__device__ __forceinline__ void tr_item8(const float* src, int ld, const float* gain, float scale, unsigned char* dst8, int dK, LAS float* scr, int lane) {
    float vr[32];
    { const float* p = src + (size_t)(lane >> 5) * ld + (lane & 31); const size_t st = (size_t)2 * ld;
#pragma unroll
      for (int i = 0; i < 32; ++i) { vr[i] = MK_NT ? __builtin_nontemporal_load(p) : *p; p += st; } }
    if (gain) { const float* gp = gain + (lane >> 5);
#pragma unroll
        for (int i = 0; i < 32; ++i) vr[i] *= gp[2 * i]; }
#pragma unroll
    for (int i = 0; i < 32; ++i) scr[(2 * i + (lane >> 5)) * 33 + (lane & 31)] = vr[i] * scale;
    LDS_WAIT(); asm volatile("" ::: "memory");
    const int c = lane & 7;
#pragma unroll
    for (int j = 0; j < 4; ++j) { const int n = (lane >> 3) + 8 * j; const LAS float* s = scr + (8 * c) * 33 + n;
        const unsigned lo = pg8::pack4_fp8(s[0 * 33], s[1 * 33], s[2 * 33], s[3 * 33]), hi = pg8::pack4_fp8(s[4 * 33], s[5 * 33], s[6 * 33], s[7 * 33]);
        if (MK_NT) __builtin_nontemporal_store((unsigned long long)lo | ((unsigned long long)hi << 32), (GAS unsigned long long*)(dst8 + (size_t)n * dK + 8 * c)); else *(GAS unsigned long long*)(dst8 + (size_t)n * dK + 8 * c) = (unsigned long long)lo | ((unsigned long long)hi << 32); }
    LDS_WAIT(); asm volatile("" ::: "memory");
}
__device__ __forceinline__ void tr_job(const float* W, int K, int ld, int c0, int nc, const float* gain, bf16* dst, int IL, int iloff, int item, LAS float* scr, int lane, float f8scale) {
    const int nblk = nc / 32, kb = item / nblk, nb = item % nblk, k0 = 64 * kb, n0 = 32 * nb;
    const int orow = (IL ? 256 * (n0 / 128) + (n0 % 128) : n0) + iloff;
    if (f8scale != 0.f) tr_item8(W + (size_t)k0 * ld + c0 + n0, ld, gain ? gain + k0 : nullptr, f8scale, (unsigned char*)dst + (size_t)orow * K + k0, K, scr, lane);
    else tr_item(W + (size_t)k0 * ld + c0 + n0, ld, gain ? gain + k0 : nullptr, dst + (size_t)orow * K + k0, K, scr, lane);
}
namespace cv {
constexpr int I_INA = 16 * 48, I_INB = 16 * 64, I_OUT = 16 * 32, I_PLE = 4 * 32, I_PG = 16 * 32, I_FG = 16 * 88, I_FD = 44 * 32, I_EG = 16 * 112, I_ED = 56 * 32;
constexpr int T_L = I_INA + I_INB + I_OUT + I_PLE + I_PG;
constexpr int T_F = 2 * I_FG + I_FD;
constexpr int T_E = 2 * I_EG + I_ED;
constexpr int NITEMS = 4 * T_L + 2 * T_F + 16 * T_E;
constexpr int E3_LO = 8 * T_E;
constexpr int Q_IN0 = MK_Q_IN, Q_IN1 = MK_Q_IN, Q_IN2 = MK_Q_IN, Q_IN3 = F8IN(3) ? MK_Q_IN8 : MK_Q_IN;
constexpr int Q_UP0 = F8DENSE(0) ? MK_Q_UP8 : MK_Q_UP, Q_UP2 = F8DENSE(1) ? MK_Q_UP8 : MK_Q_UP, Q_MUP = 6500;
constexpr int D1A = Q_IN0, D1B = D1A + Q_IN1, D1N = D1B + Q_UP0;
constexpr int Q_SC = MK_Q_SC;
constexpr int QB = MK_QB, NB1 = 15, NB3 = 19;
constexpr int D3A = Q_IN2, D3B = D3A + Q_IN3, D3C = D3B + Q_UP2, D3N = D3C + Q_MUP;
static_assert(D1N <= E3_LO && D3N <= E3_LO, "deferred ranges");
constexpr int BAR1 = D1N + 2 * Q_SC, BAR3 = E3_LO + D3N + 2 * Q_SC;
static_assert(BAR1 <= E3_LO && BAR3 <= 16 * T_E && QB % 256 == 0 && QB <= 1536, "deferred ranges");
__device__ __forceinline__ void bar_range(int step, int& lo, int& hi) {
    if (step < NB1) { lo = BAR1 + step * QB; hi = lo + QB < E3_LO ? lo + QB : E3_LO; }
    else if (step < NB1 + NB3) { lo = BAR3 + (step - NB1) * QB; hi = lo + QB < 16 * T_E ? lo + QB : 16 * T_E; }
    else { lo = 0; hi = 0; }
}
}
__device__ __forceinline__ void conv_item(Frame& F, int it, LAS float* scr, int lane) {
    using namespace cv;
    const float *w_in = KIN(F, 2), *w_out = KIN(F, 7), *mix_gain = KIN(F, 8), *ffn_gain = KIN(F, 9), *ple_gain = KIN(F, 10), *w_fg = KIN(F, 11), *w_fu = KIN(F, 12), *w_fd = KIN(F, 13),
                *w_router = KIN(F, 14), *w_eg = KIN(F, 15), *w_eu = KIN(F, 16), *w_ed = KIN(F, 17), *w_ple = KIN(F, 18), *w_pg = KIN(F, 19);
    bf16* Win = (bf16*)(F.ws + WS_WIN); bf16* Wout = (bf16*)(F.ws + WS_WOUT); bf16* Wple = (bf16*)(F.ws + WS_WPLE); bf16* Wpg = (bf16*)(F.ws + WS_WPG);
    bf16* Wgu = (bf16*)(F.ws + WS_WGU); bf16* Wd = (bf16*)(F.ws + WS_WD); bf16* Wegu = (bf16*)(F.ws + WS_WEGU); bf16* Wed = (bf16*)(F.ws + WS_WED);
        int r = it; const float* W; int K, ld, c0, nc, IL = 0, iloff = 0; const float* g = nullptr; bf16* dst;
        float f8s = 0.f;
        if (r < 16 * T_E) { const int je = r / T_E, j = je / 8; r %= T_E; K = D; ld = DEXP; c0 = 0; nc = DEXP; g = ffn_gain + (2 * j + 1) * D; dst = Wegu + (size_t)je * 2 * DEXP * D; IL = 1;
            const bool f8 = MK_FP8_LAST && (j == 1 || MK_FP8_L1);
            if (f8) { dst = (bf16*)((unsigned char*)(Wegu + (size_t)j * 8 * 2 * DEXP * D) + (size_t)(je - 8 * j) * 2 * DEXP * D); f8s = F8_SWU; }
            if (r < I_EG) { W = w_eg + (size_t)je * D * DEXP; }
            else if (r < 2 * I_EG) { r -= I_EG; W = w_eu + (size_t)je * D * DEXP; iloff = 128; }
            else { r -= 2 * I_EG; W = w_ed + (size_t)je * DEXP * D; K = DEXP; ld = D; nc = D; g = nullptr; dst = Wed + (size_t)je * D * DEXP; IL = 0;
                if (f8) { dst = (bf16*)((unsigned char*)(Wed + (size_t)j * 8 * D * DEXP) + (size_t)(je - 8 * j) * D * DEXP); f8s = F8_SWD; } } }
        else if (r < 16 * T_E + 2 * T_F) { r -= 16 * T_E; const int j = r / T_F; r %= T_F; K = D; ld = DFF; c0 = 0; nc = DFF; g = ffn_gain + (2 * j) * D; dst = Wgu + (size_t)j * 2 * DFF * D; IL = 1;
            if (F8DENSE(j)) f8s = F8_SWU;
            if (r < I_FG) { W = w_fg + (size_t)j * D * DFF; }
            else if (r < 2 * I_FG) { r -= I_FG; W = w_fu + (size_t)j * D * DFF; iloff = 128; }
            else { r -= 2 * I_FG; W = w_fd + (size_t)j * DFF * D; K = DFF; ld = D; nc = D; g = nullptr; dst = Wd + (size_t)j * D * DFF; IL = 0; if (F8DENSE(j)) f8s = F8_SWD; } }
        else { r -= 16 * T_E + 2 * T_F; const int i = r / T_L; r %= T_L; K = D; c0 = 0;
            if (r < I_INA) { W = w_in + (size_t)i * D * DIN; ld = DIN; nc = 1536; g = mix_gain + i * D; dst = Win + (size_t)i * NIN * D; if (F8IN(i)) f8s = F8_SWU; }
            else if (r < I_INA + I_INB) { r -= I_INA; W = w_in + (size_t)i * D * DIN; ld = DIN; c0 = 1544; nc = 2048; g = mix_gain + i * D; dst = Win + (size_t)i * NIN * D; iloff = 1536; if (F8IN(i)) f8s = F8_SWU; }
            else if (r < I_INA + I_INB + I_OUT) { r -= I_INA + I_INB; W = w_out + (size_t)i * D * D; ld = D; nc = D; dst = Wout + (size_t)i * D * D; }
            else if (r < I_INA + I_INB + I_OUT + I_PLE) { r -= I_INA + I_INB + I_OUT; W = w_ple + (size_t)i * DPLE * D; K = DPLE; ld = D; nc = D; dst = Wple + (size_t)i * D * DPLE; }
            else { r -= I_INA + I_INB + I_OUT + I_PLE; W = w_pg + (size_t)i * D * D; ld = D; nc = D; g = ple_gain + i * D; dst = Wpg + (size_t)i * D * D; } }
        tr_job(W, K, ld, c0, nc, g, dst, IL, iloff, r, scr, lane, f8s);
}
__device__ __forceinline__ void conv_range(Frame& F, int lo, int hi, int rank, int nranks) {
    LAS float* scr = (LAS float*)(F.lds + RING_OFF + F.wave * 16384);
    for (int it = lo + rank * NWAVES + F.wave; it < hi; it += nranks * NWAVES) conv_item(F, it, scr, F.lane);
}
constexpr int PB_SHARES = 17;
__device__ __forceinline__ void pb_barrier_share(Frame& F, int step, int lane) {
    const float* p = KIN(F, 1); bf16* pb = (bf16*)(F.ws + WS_PB);
    constexpr size_t C0 = (size_t)M * DPLE / 8, NC = 3 * C0, PER = (NC + PB_SHARES - 1) / PB_SHARES;
    const size_t lo = C0 + (size_t)step * PER, hi = (lo + PER < C0 + NC) ? lo + PER : C0 + NC;
    for (size_t idx = lo + (size_t)(F.bx * 2 + (F.wave - 2)) * 64 + lane; idx < hi; idx += (size_t)256 * 2 * 64) { const f32x4 a = __builtin_nontemporal_load((const f32x4*)(p + idx * 8)), b = __builtin_nontemporal_load((const f32x4*)(p + idx * 8 + 4));
        v4u o; o.x = pg8::cvt_pk_bf16(a[0], a[1]); o.y = pg8::cvt_pk_bf16(a[2], a[3]); o.z = pg8::cvt_pk_bf16(b[0], b[1]); o.w = pg8::cvt_pk_bf16(b[2], b[3]); *(v4u*)(pb + idx * 8) = o; }
}
__device__ __forceinline__ void p0_prologue(Frame& F) {
    using namespace cv;
    const int gw = F.gw, NGW = F.NGW, lane = F.lane;
    const float *w_in = KIN(F, 2), *mix_gain = KIN(F, 8), *ffn_gain = KIN(F, 9), *w_router = KIN(F, 14);
    bf16* Win = (bf16*)(F.ws + WS_WIN);
    { LAS float* scr = (LAS float*)(F.lds + RING_OFF + F.wave * 16384);
      if (F.G == 256) {
          constexpr int S1 = (BAR1 + NB1 * QB < E3_LO) ? BAR1 + NB1 * QB : E3_LO, S2 = (BAR3 + NB3 * QB < 16 * T_E) ? BAR3 + NB3 * QB : 16 * T_E, N1 = E3_LO - S1, N2 = NITEMS - S2;
          static_assert(N1 >= 0 && N2 >= 0, "deferred ranges");
          for (int k = gw; k < N1 + N2; k += NGW) conv_item(F, k < N1 ? S1 + k : S2 + (k - N1), scr, lane);
      } else { for (int it = gw; it < NITEMS; it += NGW) conv_item(F, it, scr, lane); } }
    const int gt = gw * 64 + lane, NGT = NGW * 64;
    for (int idx = gt; idx < 4 * 256 * 128; idx += NGT) { const int i = idx / (256 * 128), rr = (idx / 128) % 256, kc = (idx % 128) * 8; float v[8];
#pragma unroll
        for (int q = 0; q < 8; ++q) v[q] = (rr < 8) ? w_in[(size_t)i * D * DIN + (size_t)(kc + q) * DIN + 1536 + rr] * mix_gain[i * D + kc + q] : 0.f;
        if (F8IN(i)) { pg8::u32x2 o8; o8.x = pg8::pack4_fp8(v[0] * F8_SWU, v[1] * F8_SWU, v[2] * F8_SWU, v[3] * F8_SWU); o8.y = pg8::pack4_fp8(v[4] * F8_SWU, v[5] * F8_SWU, v[6] * F8_SWU, v[7] * F8_SWU);
            *(pg8::u32x2*)((unsigned char*)(Win + (size_t)i * NIN * D) + (size_t)(3584 + rr) * D + kc) = o8; }
        else { v4u o; o.x = pg8::cvt_pk_bf16(v[0], v[1]); o.y = pg8::cvt_pk_bf16(v[2], v[3]); o.z = pg8::cvt_pk_bf16(v[4], v[5]); o.w = pg8::cvt_pk_bf16(v[6], v[7]);
        *(v4u*)(Win + (size_t)i * NIN * D + (size_t)(3584 + rr) * D + kc) = o; } }
    { float* wr = (float*)(F.ws + WS_WR); for (int idx = gt; idx < 2 * NE * D; idx += NGT) { const int j = idx / (NE * D), e = (idx / D) % NE, k = idx % D; wr[idx] = w_router[(size_t)j * D * NE + (size_t)k * NE + e] * ffn_gain[(2 * j + 1) * D + k]; } }
    { float* lb = (float*)(F.ws + WS_LB); const float* lg = KIN(F, 5);
      for (int c = gt; c < 512; c += NGT) { float l[4], mx = -1e30f; for (int i = 0; i < 4; ++i) { l[i] = lg[i * 512 + c]; mx = fmaxf(mx, l[i]); } float s = 0.f; for (int i = 0; i < 4; ++i) { l[i] = __expf(l[i] - mx); s += l[i]; }
          float cum = 0.f; for (int i = 0; i < 4; ++i) { lb[i * 512 + c] = cum; if (i < 3) cum += l[i + 1] / s; } } }
    { const float* p = KIN(F, 1); bf16* pb = (bf16*)(F.ws + WS_PB);
      const size_t npb = (size_t)((F.G == 256 && QB > 0) ? 1 : DEPTH) * M * DPLE / 8;
      for (size_t idx = gt; idx < npb; idx += NGT) { const f32x4 a = __builtin_nontemporal_load((const f32x4*)(p + idx * 8)), b = __builtin_nontemporal_load((const f32x4*)(p + idx * 8 + 4));
          v4u o; o.x = pg8::cvt_pk_bf16(a[0], a[1]); o.y = pg8::cvt_pk_bf16(a[2], a[3]); o.z = pg8::cvt_pk_bf16(b[0], b[1]); o.w = pg8::cvt_pk_bf16(b[2], b[3]); *(v4u*)(pb + idx * 8) = o; } }
    { const float* x = KIN(F, 0); bf16* hb = (bf16*)(F.ws + WS_HB); float* ssq = (float*)(F.ws + WS_SSQ);
      for (int m = gw; m < M; m += NGW) { const f32x4* xr = (const f32x4*)(x + (size_t)m * D) + lane; f32x4 v[4]; float s = 0.f;
#pragma unroll
          for (int j = 0; j < 4; ++j) { v[j] = __builtin_nontemporal_load(xr + 64 * j); s += (v[j][0] * v[j][0] + v[j][1] * v[j][1]) + (v[j][2] * v[j][2] + v[j][3] * v[j][3]); }
          s = wave_sum(s);
          unsigned long long* o8 = (unsigned long long*)(hb + (size_t)m * D) + lane;
#pragma unroll
          for (int j = 0; j < 4; ++j) o8[64 * j] = (unsigned long long)pg8::cvt_pk_bf16(v[j][0], v[j][1]) | ((unsigned long long)pg8::cvt_pk_bf16(v[j][2], v[j][3]) << 32);
          if (lane == 0) ssq[m] = s; }
      for (int i = gt; i < 15 * M / 4; i += NGT) ((f32x4*)(ssq + M))[i] = (f32x4){0.f, 0.f, 0.f, 0.f}; }
}
__device__ __forceinline__ void mall_touch(Frame& F, size_t off, size_t bytes) {
    const size_t step = (size_t)F.NGW * 64 * 128;
    const GAS unsigned char* p = F.ws + off + ((size_t)F.gw * 64 + F.lane) * 128; const GAS unsigned char* end = F.ws + off + bytes;
    for (; p < end; p += 4 * step) { unsigned t0, t1, t2, t3;
        const GAS unsigned char *p1 = p + step < end ? p + step : p, *p2 = p + 2 * step < end ? p + 2 * step : p, *p3 = p + 3 * step < end ? p + 3 * step : p;
        asm volatile("global_load_dword %0, %4, off\n\tglobal_load_dword %1, %5, off\n\tglobal_load_dword %2, %6, off\n\tglobal_load_dword %3, %7, off\n\ts_waitcnt vmcnt(0)"
                     : "=&v"(t0), "=&v"(t1), "=&v"(t2), "=&v"(t3) : "v"(p), "v"(p1), "v"(p2), "v"(p3) : "memory"); }
}
__device__ __forceinline__ void fox_cscan(Frame& F, int layer, int bh) {
    asm volatile("; CSC_BEGIN" ::: "memory");
    const float* fg = (const float*)(F.ws + WS_FG); float* cb = (float*)(F.ws + WS_CB); const float* bias = KIN(F, 3) + layer * NHEAD;
    { const int b = bh / NHEAD, h = bh % NHEAD, lane = F.lane; const float bi = bias[h];
        float x[32];
#pragma unroll
        for (int j = 0; j < 32; ++j) x[j] = fg[(size_t)(b * SEQ + j * 64 + lane) * 8 + h];
        float carry = 0.f;
#pragma unroll
        for (int j = 0; j < 32; ++j) { const float incl = wave_incl_scan(log_sigmoid_f(x[j] + bi)) + carry;
            cb[(size_t)bh * SEQ + j * 64 + lane] = incl;
            carry = __builtin_bit_cast(float, __builtin_amdgcn_readlane(__builtin_bit_cast(int, incl), 63)); } }
}
__device__ __forceinline__ void moe_route_a(Frame& F, int j) {
    asm volatile("; RA_BEGIN" ::: "memory");
    LAS float* wrl = (LAS float*)(F.lds);
    LAS int* ce = (LAS int*)(F.lds + 32768);
    const float* wr = (const float*)(F.ws + WS_WR) + (size_t)j * NE * D; const bf16* h = (const bf16*)(F.ws + WS_HB);
    int* tok_e = (int*)(F.ws + WS_TOKE); float* tok_w = (float*)(F.ws + WS_TOKW); int* rank = (int*)(F.ws + WS_RANK); float* rstd = (float*)(F.ws + WS_RSTD); int* bcnt = (int*)(F.ws + WS_BCNT);
    { float tmp[16];
#pragma unroll
      for (int i = 0; i < 16; ++i) tmp[i] = wr[F.tid + i * NWAVES * 64];
#pragma unroll
      for (int i = 0; i < 16; ++i) wrl[F.tid + i * NWAVES * 64] = tmp[i]; }
    __syncthreads();
    for (int tb = F.bx; tb < M / 64; tb += F.G) {
        f32x4 vn[4];
        { const bf16* hr0 = h + (size_t)(tb * 64 + F.wave * 8) * D + 4 * F.lane;
#pragma unroll
          for (int q = 0; q < 4; ++q) vn[q] = ldh4(hr0 + 256 * q); }
#pragma unroll
        for (int r = 0; r < 8; ++r) { const int t = tb * 64 + F.wave * 8 + r; f32x4 v[4]; float s = 0.f; float lg[NE];
#pragma unroll
            for (int q = 0; q < 4; ++q) v[q] = vn[q];
            if (r < 7) { const bf16* hr1 = h + (size_t)(t + 1) * D + 4 * F.lane;
#pragma unroll
                for (int q = 0; q < 4; ++q) vn[q] = ldh4(hr1 + 256 * q); }
#pragma unroll
            for (int q = 0; q < 4; ++q) s += (v[q][0] * v[q][0] + v[q][1] * v[q][1]) + (v[q][2] * v[q][2] + v[q][3] * v[q][3]);
#pragma unroll
            for (int e = 0; e < NE; ++e) { float a = 0.f;
#pragma unroll
                for (int q = 0; q < 4; ++q) { const f32x4 w = *(const LAS f32x4*)(wrl + e * D + 256 * q + 4 * F.lane); a += (v[q][0] * w[0] + v[q][1] * w[1]) + (v[q][2] * w[2] + v[q][3] * w[3]); }
                lg[e] = a; }
            wave_incl_scan4(lg[0], lg[1], lg[2], lg[3]); wave_incl_scan4(lg[4], lg[5], lg[6], lg[7]);
#pragma unroll
            for (int e = 0; e < NE; ++e) lg[e] = __builtin_bit_cast(float, __builtin_amdgcn_readlane(__builtin_bit_cast(int, lg[e]), 63));
            s = wave_sum(s); const float rs = rsqrtf(s * (1.0f / D) + pg8::RMS_EPS);
            if (F.lane == 0) {
#pragma unroll
                for (int e = 0; e < NE; ++e) lg[e] *= rs;
                float l0 = lg[0]; int i0 = 0;
#pragma unroll
                for (int e = 1; e < NE; ++e) if (lg[e] > l0) { l0 = lg[e]; i0 = e; }
                float l1 = -3.0e38f; int i1 = 0;
#pragma unroll
                for (int e = 0; e < NE; ++e) if (e != i0 && lg[e] > l1) { l1 = lg[e]; i1 = e; }
                const float e1 = __expf(l1 - l0); const float w0 = 1.f / (1.f + e1);
                tok_e[t * 2] = i0; tok_e[t * 2 + 1] = i1; tok_w[t * 2] = w0; tok_w[t * 2 + 1] = e1 * w0; rstd[t] = rs;
                ce[(F.wave * 8 + r) * 2] = i0; ce[(F.wave * 8 + r) * 2 + 1] = i1; }
        }
        __syncthreads();
        { LAS int* wcnt = ce + 128;
          int e = -1, rk = 0;
          if (F.wave < 2) { e = ce[F.tid];
#pragma unroll
              for (int ee = 0; ee < NE; ++ee) { const unsigned long long mk = __ballot(e == ee); if (e == ee) rk = __popcll(mk & ((1ull << F.lane) - 1ull)); if (F.lane == 0) wcnt[F.wave * 8 + ee] = __popcll(mk); } }
          __syncthreads();
          if (F.wave < 2) { if (F.wave == 1) rk += wcnt[e]; rank[(tb * 64) * 2 + F.tid] = rk; }
          if (F.tid < NE) bcnt[tb * 8 + F.tid] = wcnt[F.tid] + wcnt[8 + F.tid];
          __syncthreads(); }
    }
}
__device__ __forceinline__ void moe_route_b(Frame& F, bool f8) {
    asm volatile("; RB_BEGIN" ::: "memory");
    LAS int* tot = (LAS int*)(F.lds); LAS int* offs = tot + 8; LAS int* base = tot + 16;
    const bf16* h = (const bf16*)(F.ws + WS_HB); const int* tok_e = (const int*)(F.ws + WS_TOKE); const int* rank = (const int*)(F.ws + WS_RANK); const float* rstd = (const float*)(F.ws + WS_RSTD);
    const int* bcnt = (const int*)(F.ws + WS_BCNT); int* slot_of = (int*)(F.ws + WS_SLOT); bf16* Xg = (bf16*)(F.ws + WS_XG); int* meta = (int*)(F.ws + WS_META);
    for (int tb = F.bx; tb < M / 64; tb += F.G) {
        LAS int* part = tot + 32;
        if (F.tid < 256) { const int4 c0 = *(const int4*)(bcnt + F.tid * 8), c1 = *(const int4*)(bcnt + F.tid * 8 + 4); const int cc[8] = {c0.x, c0.y, c0.z, c0.w, c1.x, c1.y, c1.z, c1.w}; const bool lower = F.tid < tb;
#pragma unroll
            for (int e = 0; e < NE; ++e) { const float st = wave_sum((float)cc[e]), so = wave_sum(lower ? (float)cc[e] : 0.f);
                if (F.lane == 0) { part[F.wave * 16 + e] = (int)st; part[F.wave * 16 + 8 + e] = (int)so; } } }
        __syncthreads();
        if (F.tid < 16) tot[F.tid] = part[F.tid] + part[16 + F.tid] + part[32 + F.tid] + part[48 + F.tid];
        __syncthreads();
        if (F.tid == 0) { int s = 0; for (int e = 0; e < NE; ++e) { base[e] = s; s += ((tot[e] + 255) / 256) * 256; }
            if (tb == 0) { int tp = 0; for (int e = 0; e < NE; ++e) { meta[e] = tp; tp += (tot[e] + 255) / 256; } meta[8] = tp; for (int e = 0; e < NE; ++e) meta[16 + e] = tot[e]; } }
        __syncthreads();
        f32x4 vn[4]; int me0, me1, mr0, mr1; float mrs;
        { const int t0 = tb * 64 + F.wave * 8; const bf16* hr0 = h + (size_t)t0 * D + 4 * F.lane;
#pragma unroll
          for (int q = 0; q < 4; ++q) vn[q] = ldh4(hr0 + 256 * q);
          me0 = tok_e[t0 * 2]; me1 = tok_e[t0 * 2 + 1]; mr0 = rank[t0 * 2]; mr1 = rank[t0 * 2 + 1]; mrs = rstd[t0]; }
#pragma unroll
        for (int r = 0; r < 8; ++r) { const int t = tb * 64 + F.wave * 8 + r; const float rs = mrs; const int e0 = me0, e1 = me1, k0 = mr0, k1 = mr1; f32x4 v[4];
#pragma unroll
            for (int q = 0; q < 4; ++q) v[q] = vn[q];
            if (r < 7) { const bf16* hr1 = h + (size_t)(t + 1) * D + 4 * F.lane;
#pragma unroll
                for (int q = 0; q < 4; ++q) vn[q] = ldh4(hr1 + 256 * q);
                me0 = tok_e[(t + 1) * 2]; me1 = tok_e[(t + 1) * 2 + 1]; mr0 = rank[(t + 1) * 2]; mr1 = rank[(t + 1) * 2 + 1]; mrs = rstd[t + 1]; }
            const int s0 = base[e0] + offs[e0] + k0, s1 = base[e1] + offs[e1] + k1;
            if (F.lane == 0) { slot_of[t * 2] = s0; slot_of[t * 2 + 1] = s1; }
            if (f8) { unsigned* o0 = (unsigned*)((unsigned char*)Xg + (size_t)s0 * D) + F.lane; unsigned* o1 = (unsigned*)((unsigned char*)Xg + (size_t)s1 * D) + F.lane;
#pragma unroll
                for (int q = 0; q < 4; ++q) { const f32x4 x = v[q] * (rs * F8_SX); const unsigned w = pg8::pack4_fp8(x[0], x[1], x[2], x[3]); o0[64 * q] = w; o1[64 * q] = w; }
                continue; }
            unsigned long long* o0 = (unsigned long long*)(Xg + (size_t)s0 * D) + F.lane; unsigned long long* o1 = (unsigned long long*)(Xg + (size_t)s1 * D) + F.lane;
#pragma unroll
            for (int q = 0; q < 4; ++q) { const f32x4 x = v[q] * rs; const unsigned long long w = (unsigned long long)pg8::cvt_pk_bf16(x[0], x[1]) | ((unsigned long long)pg8::cvt_pk_bf16(x[2], x[3]) << 32); o0[64 * q] = w; o1[64 * q] = w; } }
        if (tb < NE) { const int e = tb, lo = base[e] + tot[e], hi = base[e] + ((tot[e] + 255) / 256) * 256;
            for (int rr = lo + F.wave; rr < hi; rr += NWAVES) {
                if (f8) { unsigned* o = (unsigned*)((unsigned char*)Xg + (size_t)rr * D) + F.lane;
#pragma unroll
                    for (int q = 0; q < 4; ++q) o[64 * q] = 0u; }
                else { unsigned long long* o = (unsigned long long*)(Xg + (size_t)rr * D) + F.lane;
#pragma unroll
                    for (int q = 0; q < 4; ++q) o[64 * q] = 0ull; } } }
        __syncthreads();
    }
}
struct CmbTok { unsigned long long hv[4]; unsigned long long a[4], b[4]; f32x4 xa[4], xb[4]; float w0, w1; };
__device__ __forceinline__ f32x4 bf4(unsigned long long a) { f32x4 r; r[0] = __uint_as_float((unsigned)a << 16); r[1] = __uint_as_float((unsigned)a & 0xffff0000u); r[2] = __uint_as_float((unsigned)(a >> 32) << 16); r[3] = __uint_as_float((unsigned)(a >> 32) & 0xffff0000u); return r; }
__device__ __forceinline__ void cmb_load(CmbTok& T, const bf16* h, const bf16* Y, const bf16* YP, const LAS int* tab, const int* slot_of, const float* tok_w, int t, int lane, int np) {
    const int s0 = slot_of[t * 2], s1 = slot_of[t * 2 + 1]; T.w0 = tok_w[t * 2]; T.w1 = tok_w[t * 2 + 1];
    const unsigned long long* hr = (const unsigned long long*)(h + (size_t)t * D) + lane; const unsigned long long* y0 = (const unsigned long long*)(Y + (size_t)s0 * D) + lane; const unsigned long long* y1 = (const unsigned long long*)(Y + (size_t)s1 * D) + lane;
#pragma unroll
    for (int q = 0; q < 4; ++q) { T.hv[q] = hr[64 * q]; T.a[q] = __builtin_nontemporal_load(y0 + 64 * q); T.b[q] = __builtin_nontemporal_load(y1 + 64 * q);     T.xa[q] = (f32x4){0.f, 0.f, 0.f, 0.f}; T.xb[q] = (f32x4){0.f, 0.f, 0.f, 0.f}; }
#pragma unroll
    for (int q = 0; q < 4; ++q) { const int i0 = tab[(s0 >> 8) * 4 + q], i1 = tab[(s1 >> 8) * 4 + q];
        if (i0) { const unsigned long long* p = (const unsigned long long*)(YP + (size_t)(i0 - 1) * np * 65536 + (size_t)(s0 & 255) * 256) + lane; T.xa[q] = bf4(__builtin_nontemporal_load(p)); for (int r = 1; r < np; ++r) T.xa[q] += bf4(__builtin_nontemporal_load(p + (size_t)r * 16384)); }
        if (i1) { const unsigned long long* p = (const unsigned long long*)(YP + (size_t)(i1 - 1) * np * 65536 + (size_t)(s1 & 255) * 256) + lane; T.xb[q] = bf4(__builtin_nontemporal_load(p)); for (int r = 1; r < np; ++r) T.xb[q] += bf4(__builtin_nontemporal_load(p + (size_t)r * 16384)); } }
}
__device__ __forceinline__ void moe_combine(Frame& F, float* ssq_out, bool f8) {
    asm volatile("; CMB_BEGIN" ::: "memory");
    bf16* hb = (bf16*)(F.ws + WS_HB); const bf16* h = hb; const bf16* Y = (const bf16*)(F.ws + WS_XG); const bf16* YP = (const bf16*)(F.ws + WS_YP); const int* slot_of = (const int*)(F.ws + WS_SLOT); const float* tok_w = (const float*)(F.ws + WS_TOKW);
    LAS int* tab = (LAS int*)(F.lds);
    int np;
    { const int* meta = (const int*)(F.ws + WS_META);
      pg8::MoeOrder S; S.nN = D / 256; S.G = F.G; S.c = 0;
#pragma unroll
      for (int e = 0; e < 9; ++e) S.tpre[e] = __builtin_amdgcn_readfirstlane(meta[e]);
      S.nM = S.tpre[8]; S.nwg = S.nM * S.nN; S.nlim = S.nwg;
      int L0, nleft; pg8::moe_split_plan(S.nwg, F.G, L0, nleft);
      np = f8 ? (nleft * 7 <= (int)F.G ? 6 : 1) : 3;
      for (int i = F.tid; i < 137 * 4; i += NWAVES * 64) tab[i] = 0;
      __syncthreads();
      if (F.tid < nleft) { pg8::Unit u; S.map(L0 + F.tid, u); tab[u.pm * 4 + u.pn] = F.tid + 1; }
      __syncthreads(); }
    for (int i = F.gw * 64 + F.lane; i < 15 * M / 4; i += F.NGW * 64) ((f32x4*)(ssq_out + M))[i] = (f32x4){0.f, 0.f, 0.f, 0.f};
    CmbTok cur, nxt; int t = F.gw;
    if (t < M) cmb_load(cur, h, Y, YP, tab, slot_of, tok_w, t, F.lane, np);
    for (; t < M; t += F.NGW) { const int tn = t + F.NGW;
        if (tn < M) cmb_load(nxt, h, Y, YP, tab, slot_of, tok_w, tn, F.lane, np);
        unsigned long long* o8 = (unsigned long long*)(hb + (size_t)t * D) + F.lane; float s = 0.f; const float w0 = cur.w0, w1 = cur.w1;
#pragma unroll
        for (int q = 0; q < 4; ++q) { const f32x4 v = bf4(cur.hv[q]) + w0 * (bf4(cur.a[q]) + cur.xa[q]) + w1 * (bf4(cur.b[q]) + cur.xb[q]);
            s += (v[0] * v[0] + v[1] * v[1]) + (v[2] * v[2] + v[3] * v[3]);
            o8[64 * q] = (unsigned long long)pg8::cvt_pk_bf16(v[0], v[1]) | ((unsigned long long)pg8::cvt_pk_bf16(v[2], v[3]) << 32); }
        s = wave_sum(s);
        if (F.lane == 0) ssq_out[t] = s;
        cur = nxt; }
}
__device__ __forceinline__ void final_norm(Frame& F) {
    const bf16* h = (const bf16*)(F.ws + WS_HB); const f32x4* g = (const f32x4*)KIN(F, 20) + F.lane;
    f32x4 gq[4];
#pragma unroll
    for (int q = 0; q < 4; ++q) gq[q] = g[64 * q];
    for (int t = F.gw; t < M; t += 2 * F.NGW) { const int t2 = t + F.NGW; const bool two = t2 < M;
        const bf16* hr = h + (size_t)t * D + 4 * F.lane; const bf16* hr2 = h + (size_t)(two ? t2 : t) * D + 4 * F.lane; f32x4 v[4], w[4]; float s = 0.f, s2 = 0.f;
#pragma unroll
        for (int q = 0; q < 4; ++q) { v[q] = ldh4nt(hr + 256 * q); w[q] = ldh4nt(hr2 + 256 * q); }
#pragma unroll
        for (int q = 0; q < 4; ++q) { s += (v[q][0] * v[q][0] + v[q][1] * v[q][1]) + (v[q][2] * v[q][2] + v[q][3] * v[q][3]); s2 += (w[q][0] * w[q][0] + w[q][1] * w[q][1]) + (w[q][2] * w[q][2] + w[q][3] * w[q][3]); }
        s = wave_sum(s); s2 = wave_sum(s2); const float rs = rsqrtf(s * (1.0f / D) + pg8::RMS_EPS), rs2 = rsqrtf(s2 * (1.0f / D) + pg8::RMS_EPS);
        f32x4* o = (f32x4*)(F.out + (size_t)t * D) + F.lane; f32x4* o2 = (f32x4*)(F.out + (size_t)t2 * D) + F.lane;
#pragma unroll
        for (int q = 0; q < 4; ++q) __builtin_nontemporal_store(v[q] * rs * gq[q], o + 64 * q);
        if (two) {
#pragma unroll
            for (int q = 0; q < 4; ++q) __builtin_nontemporal_store(w[q] * rs2 * gq[q], o2 + 64 * q); } }
}
typedef float f32x16_t __attribute__((ext_vector_type(16)));
constexpr float LOG2E = 1.4426950408889634f;
__device__ __forceinline__ float exp_f(float x) { return __builtin_amdgcn_exp2f(x * LOG2E); }
__device__ __forceinline__ float bfbits2f(unsigned short u) { return __uint_as_float((unsigned)u << 16); }
__device__ __forceinline__ int crow_(int r, int hi) { return (r & 3) + 8 * (r >> 2) + 4 * hi; }
__device__ __forceinline__ bf16x8 mk8(unsigned a, unsigned b, unsigned c, unsigned d) { v4u t; t.x = a; t.y = b; t.z = c; t.w = d; return __builtin_bit_cast(bf16x8, t); }
__device__ __forceinline__ void stage_tile64(const bf16* src, LAS unsigned char* dst, int lane) {
    v4u x[8]; const GAS bf16* p = (const GAS bf16*)(src + (size_t)(lane >> 3) * 512 + (lane & 7) * 8);
#pragma unroll
    for (int i = 0; i < 8; ++i) { x[i] = __builtin_nontemporal_load((const GAS v4u*)p); p += 8 * 512; asm volatile("" : "+v"(p)); }
#pragma unroll
    for (int i = 0; i < 8; ++i) *(LAS v4u*)(dst + ((lane >> 3) + 8 * i) * 128 + (lane & 7) * 16) = x[i];
}
__device__ __forceinline__ void stage_tile64x2(const bf16* srcA, LAS unsigned char* dstA, const bf16* srcB, LAS unsigned char* dstB, int lane) {
    v4u x[8], y[8]; const GAS bf16* p = (const GAS bf16*)(srcA + (size_t)(lane >> 3) * 512 + (lane & 7) * 8); const GAS bf16* q = (const GAS bf16*)(srcB + (size_t)(lane >> 3) * 512 + (lane & 7) * 8);
#pragma unroll
    for (int i = 0; i < 8; ++i) { x[i] = *(const GAS v4u*)p; y[i] = *(const GAS v4u*)q; p += 8 * 512; q += 8 * 512; asm volatile("" : "+v"(p), "+v"(q)); }
#pragma unroll
    for (int i = 0; i < 8; ++i) { *(LAS v4u*)(dstA + ((lane >> 3) + 8 * i) * 128 + (lane & 7) * 16) = x[i]; *(LAS v4u*)(dstB + ((lane >> 3) + 8 * i) * 128 + (lane & 7) * 16) = y[i]; }
}
__device__ __forceinline__ float rdlane_f(float v, int l) { return __builtin_bit_cast(float, __builtin_amdgcn_readlane(__builtin_bit_cast(int, v), l)); }
__device__ __forceinline__ float log2_f(float x) { return __builtin_amdgcn_logf(x); }
typedef short s16x4h __attribute__((ext_vector_type(4)));
__device__ __forceinline__ s16x4h lds_tr4(const LAS unsigned char* p) { return __builtin_bit_cast(s16x4h, __builtin_amdgcn_ds_read_tr16_b64_v4i16((LAS s16x4h*)p)); }
__device__ __forceinline__ bf16x8 cat44(s16x4h a, s16x4h b) { return __builtin_shufflevector(a, b, 0, 1, 2, 3, 4, 5, 6, 7); }
__device__ __forceinline__ int tr_lane_off(int lane, int half_rows) { const int g = lane >> 4, ix = lane & 15; return (half_rows * (g >> 1) + (ix >> 2)) * 128 + (16 * (g & 1) + 4 * (ix & 3)) * 2; }
__device__ __forceinline__ void hgrn_pass1(Frame& F, int layer) {
    const bf16* zb = (const bf16*)(F.ws + WS_ZB); const bf16* HF = zb + 4 * ZARR; const bf16* HI = zb + 5 * ZARR;
    const float* lb = (const float*)(F.ws + WS_LB) + layer * 512; float* Lt = (float*)(F.ws + WS_HL); float* gd = (float*)(F.ws + WS_HG_);
    LAS unsigned char* wl = F.lds + RING_OFF + F.wave * 16384;
    for (int item = F.gw; item < 2048; item += F.NGW) {
        int lane = F.lane; asm volatile("" : "+v"(lane));
        const int dl = lane & 31, tq = lane >> 5;
        const int bh = item >> 5, c = item & 31, b = bh >> 3, h = bh & 7; const size_t row0 = (size_t)b * SEQ + c * 64;
        const float lbv0 = lb[h * 64 + dl], lbv1 = lb[h * 64 + dl + 32];
        stage_tile64x2(HI + row0 * 512 + h * 64, wl, HF + row0 * 512 + h * 64, wl + 8192, lane);
        LDS_WAIT();
        const int trb = tr_lane_off(lane, 32);
        bf16x8 Vop[2][4];
#pragma unroll
        for (int nt = 0; nt < 2; ++nt)
#pragma unroll
            for (int s = 0; s < 4; ++s) {
#if MK_TRREAD
                Vop[nt][s] = cat44(lds_tr4(wl + trb + (8 * s) * 128 + 64 * nt), lds_tr4(wl + trb + (8 * s + 4) * 128 + 64 * nt));
#else
                unsigned w[4];
#pragma unroll
                for (int jj = 0; jj < 4; ++jj) { const unsigned lo = *(const LAS unsigned short*)(wl + (32 * tq + 8 * s + 2 * jj) * 128 + (dl + 32 * nt) * 2), hi = *(const LAS unsigned short*)(wl + (32 * tq + 8 * s + 2 * jj + 1) * 128 + (dl + 32 * nt) * 2); w[jj] = lo | (hi << 16); }
                Vop[nt][s] = mk8(w[0], w[1], w[2], w[3]);
#endif
            }
        f32x16_t acc[2][2];
        { float z0 = 0.f; asm volatile("" : "+v"(z0));
#pragma unroll
          for (int r = 0; r < 16; ++r) { acc[0][0][r] = z0; acc[0][1][r] = z0; acc[1][0][r] = z0; acc[1][1][r] = z0; } }
#pragma unroll
        for (int dh = 0; dh < 2; ++dh) { const int d = dl + 32 * dh; const float lbv = dh ? lbv1 : lbv0, oml = 1.f - lbv;
            float bl[32], kk[32];
#if MK_TRREAD
            s16x4h zt[8];
#pragma unroll
            for (int ib = 0; ib < 8; ++ib) zt[ib] = lds_tr4(wl + 8192 + trb + (4 * ib) * 128 + 64 * dh);
#endif
#pragma unroll
            for (int i = 0; i < 32; ++i) {
#if MK_TRREAD
                const float z = __uint_as_float((unsigned)(unsigned short)zt[i >> 2][i & 3] << 16);
#else
                const float z = bfbits2f(*(const LAS unsigned short*)(wl + 8192 + (32 * tq + i) * 128 + d * 2));
#endif

                const float sn = __builtin_amdgcn_rcpf(1.f + __builtin_amdgcn_exp2f(z * LOG2E)); const float k = oml * sn; kk[i] = k; bl[i] = log2_f(1.f - k); }
#pragma unroll
            for (int i = 1; i < 32; ++i) bl[i] += bl[i - 1];
            const float tot = bl[31];
            const auto rr = __builtin_amdgcn_permlane32_swap(__float_as_uint(tot), __float_as_uint(tot), false, false);
            const float tot_lo = tq ? __uint_as_float(rr[0]) : tot, tot_hi = tq ? tot : __uint_as_float(rr[1]);
            const float bend = tot_lo + tot_hi, off = tq ? tot_lo : 0.f;
            if (tq == 0) gd[(size_t)item * 64 + d] = __builtin_amdgcn_exp2f(bend);
            bf16x8 Aop[4];
#pragma unroll
            for (int s = 0; s < 4; ++s) { unsigned w[4];
#pragma unroll
                for (int jj = 0; jj < 4; ++jj) { const int i0 = 8 * s + 2 * jj; w[jj] = pg8::cvt_pk_bf16(kk[i0] * __builtin_amdgcn_exp2f(bend - (bl[i0] + off)), kk[i0 + 1] * __builtin_amdgcn_exp2f(bend - (bl[i0 + 1] + off))); }
                Aop[s] = mk8(w[0], w[1], w[2], w[3]); }
#pragma unroll
            for (int nt = 0; nt < 2; ++nt)
#pragma unroll
                for (int s = 0; s < 4; ++s) acc[dh][nt] = __builtin_amdgcn_mfma_f32_32x32x16_bf16(Aop[s], Vop[nt][s], acc[dh][nt], 0, 0, 0);
        }
        float* Lo = Lt + (size_t)item * 4096;
#pragma unroll
        for (int dh = 0; dh < 2; ++dh)
#pragma unroll
            for (int nt = 0; nt < 2; ++nt)
#pragma unroll
                for (int g = 0; g < 4; ++g) { f32x4 val; val[0] = acc[dh][nt][4 * g]; val[1] = acc[dh][nt][4 * g + 1]; val[2] = acc[dh][nt][4 * g + 2]; val[3] = acc[dh][nt][4 * g + 3];
                    if (MK_LT16) { pg8::u32x2 w; w.x = pg8::cvt_pk_bf16(val[0], val[1]); w.y = pg8::cvt_pk_bf16(val[2], val[3]); *(pg8::u32x2*)((bf16*)Lt + (size_t)item * 4096 + (32 * nt + dl) * 64 + 32 * dh + 8 * g + 4 * tq) = w; }
                    else *(f32x4*)(Lo + (32 * nt + dl) * 64 + 32 * dh + 8 * g + 4 * tq) = val; }
        LDS_WAIT(); asm volatile("" ::: "memory");
    }
    asm volatile("; P3_END" ::: "memory");
}
__device__ __forceinline__ void hgrn_scan(Frame& F) {
    const float* Lt = (const float*)(F.ws + WS_HL); const float* gd = (const float*)(F.ws + WS_HG_); bf16* St = (bf16*)(F.ws + WS_HS);
    if (F.tid >= 256) return;
    for (int task = F.bx * 256 + F.tid; task < 65536; task += F.G * 256) {
        const int bh = task >> 10, v = (task >> 4) & 63, d0 = (task & 15) * 4;
        f32x4 cur = (f32x4){0.f, 0.f, 0.f, 0.f};
#pragma unroll 16
        for (int c = 0; c < 32; ++c) { const size_t item = (size_t)bh * 32 + c;
            f32x4 L; if (MK_LT16) { const pg8::u32x2 w = __builtin_nontemporal_load((const pg8::u32x2*)((const bf16*)Lt + item * 4096 + v * 64 + d0)); L[0] = __uint_as_float(w.x << 16); L[1] = __uint_as_float(w.x & 0xffff0000u); L[2] = __uint_as_float(w.y << 16); L[3] = __uint_as_float(w.y & 0xffff0000u); }
            else L = __builtin_nontemporal_load((const f32x4*)(Lt + item * 4096 + v * 64 + d0));
            const f32x4 g = *(const f32x4*)(gd + item * 64 + d0);
            pg8::u32x2 w; w.x = pg8::cvt_pk_bf16(cur[0], cur[1]); w.y = pg8::cvt_pk_bf16(cur[2], cur[3]); *(pg8::u32x2*)(St + item * 4096 + v * 64 + d0) = w;
            cur = g * cur + L; }
    }
}
__device__ __forceinline__ void hgrn_pass3(Frame& F, int layer) {
    asm volatile("; P3_BEGIN" ::: "memory");
    const bf16* zb = (const bf16*)(F.ws + WS_ZB); const bf16* HQ = zb + 3 * ZARR; const bf16* HF = zb + 4 * ZARR; const bf16* HI = zb + 5 * ZARR; const bf16* HG = zb + 6 * ZARR;
    const float* lb = (const float*)(F.ws + WS_LB) + layer * 512; const bf16* St = (const bf16*)(F.ws + WS_HS); const float* gain = KIN(F, 6) + layer * 512; bf16* mix = (bf16*)(F.ws + WS_MIX);
    LAS unsigned char* wl = F.lds + RING_OFF + F.wave * 16384;
    for (int item = F.gw; item < 2048; item += F.NGW) {
        int lane = F.lane; asm volatile("" : "+v"(lane));
        const int vl = lane & 31, hi = lane >> 5;
        const int bh = item >> 5, c = item & 31, b = bh >> 3, h = bh & 7; const size_t row0 = (size_t)b * SEQ + c * 64; const size_t row = row0 + lane;
        const float lbl = lb[h * 64 + lane], gnl = gain[h * 64 + lane];
        stage_tile64(HI + row0 * 512 + h * 64, wl, lane);
        f32x16_t out[2][2], sc[3];
        { float z0 = 0.f; asm volatile("" : "+v"(z0));
#pragma unroll
          for (int r = 0; r < 16; ++r) { out[0][0][r] = z0; out[0][1][r] = z0; out[1][0][r] = z0; out[1][1][r] = z0; sc[0][r] = z0; sc[1][r] = z0; sc[2][r] = z0; } }
#pragma unroll
        for (int s = 0; s < 4; ++s) {
            const v4u zf0 = *(const v4u*)(HF + row * 512 + h * 64 + 16 * s), zf1 = *(const v4u*)(HF + row * 512 + h * 64 + 16 * s + 8);
            const v4u q0 = *(const v4u*)(HQ + row * 512 + h * 64 + 16 * s), q1 = *(const v4u*)(HQ + row * 512 + h * 64 + 16 * s + 8);
            const unsigned zw[8] = {zf0.x, zf0.y, zf0.z, zf0.w, zf1.x, zf1.y, zf1.z, zf1.w}; const unsigned qw[8] = {q0.x, q0.y, q0.z, q0.w, q1.x, q1.y, q1.z, q1.w};
            float qd[16], qm[16], km[16];
#if MK_SCAN4
            float kv[16], xv[16];
#pragma unroll
            for (int i = 0; i < 16; ++i) { const float z = (i & 1) ? __uint_as_float(zw[i >> 1] & 0xffff0000u) : __uint_as_float(zw[i >> 1] << 16);
                const float lbv = rdlane_f(lbl, 16 * s + i); const float sn = __builtin_amdgcn_rcpf(1.f + __builtin_amdgcn_exp2f(z * LOG2E)); kv[i] = (1.f - lbv) * sn; xv[i] = log2_f(1.f - kv[i]); }
#pragma unroll
            for (int i = 0; i < 16; i += 4) wave_incl_scan4(xv[i], xv[i + 1], xv[i + 2], xv[i + 3]);
#endif
#pragma unroll
            for (int i = 0; i < 16; ++i) {
                const float q = (i & 1) ? __uint_as_float(qw[i >> 1] & 0xffff0000u) : __uint_as_float(qw[i >> 1] << 16);
#if MK_SCAN4
                const float k = kv[i], bb = xv[i];
#else
                const float z = (i & 1) ? __uint_as_float(zw[i >> 1] & 0xffff0000u) : __uint_as_float(zw[i >> 1] << 16);
                const float lbv = rdlane_f(lbl, 16 * s + i); const float sn = __builtin_amdgcn_rcpf(1.f + __builtin_amdgcn_exp2f(z * LOG2E)); const float k = (1.f - lbv) * sn;
                const float bb = wave_incl_scan(log2_f(1.f - k));
#endif
                const float bmid = __builtin_bit_cast(float, __builtin_amdgcn_readlane(__builtin_bit_cast(int, bb), 31));
                qd[i] = q * __builtin_amdgcn_exp2f(bb); qm[i] = q * __builtin_amdgcn_exp2f(fminf(bb - bmid, 115.f)); km[i] = k * __builtin_amdgcn_exp2f(fminf(bmid - bb, 115.f)); }
            unsigned QdL[4], QdH[4], QmL[4], QmH[4], KmL[4], KmH[4];
#pragma unroll
            for (int jj = 0; jj < 4; ++jj) { QdL[jj] = pg8::cvt_pk_bf16(qd[2 * jj], qd[2 * jj + 1]); QdH[jj] = pg8::cvt_pk_bf16(qd[8 + 2 * jj], qd[9 + 2 * jj]);
                QmL[jj] = pg8::cvt_pk_bf16(qm[2 * jj], qm[2 * jj + 1]); QmH[jj] = pg8::cvt_pk_bf16(qm[8 + 2 * jj], qm[9 + 2 * jj]);
                KmL[jj] = pg8::cvt_pk_bf16(km[2 * jj], km[2 * jj + 1]); KmH[jj] = pg8::cvt_pk_bf16(km[8 + 2 * jj], km[9 + 2 * jj]); }
            unsigned Qd0[4], Qd1[4], Qm0[4], Qm1[4], Km0[4], Km1[4];
#pragma unroll
            for (int jj = 0; jj < 4; ++jj) { auto r1 = __builtin_amdgcn_permlane32_swap(QdL[jj], QdH[jj], false, false); Qd0[jj] = r1[0]; Qd1[jj] = r1[1];
                auto r2 = __builtin_amdgcn_permlane32_swap(QmL[jj], QmH[jj], false, false); Qm0[jj] = r2[0]; Qm1[jj] = r2[1];
                auto r3 = __builtin_amdgcn_permlane32_swap(KmL[jj], KmH[jj], false, false); Km0[jj] = r3[0]; Km1[jj] = r3[1]; }
            const bf16x8 aQd0 = mk8(Qd0[0], Qd0[1], Qd0[2], Qd0[3]), aQd1 = mk8(Qd1[0], Qd1[1], Qd1[2], Qd1[3]), aQm0 = mk8(Qm0[0], Qm0[1], Qm0[2], Qm0[3]), aQm1 = mk8(Qm1[0], Qm1[1], Qm1[2], Qm1[3]),
                         aKm0 = mk8(Km0[0], Km0[1], Km0[2], Km0[3]), aKm1 = mk8(Km1[0], Km1[1], Km1[2], Km1[3]);
            const bf16x8 So0 = *(const bf16x8*)(St + (size_t)item * 4096 + (vl) * 64 + 16 * s + 8 * hi), So1 = *(const bf16x8*)(St + (size_t)item * 4096 + (vl + 32) * 64 + 16 * s + 8 * hi);
            out[0][0] = __builtin_amdgcn_mfma_f32_32x32x16_bf16(aQd0, So0, out[0][0], 0, 0, 0); out[0][1] = __builtin_amdgcn_mfma_f32_32x32x16_bf16(aQd0, So1, out[0][1], 0, 0, 0);
            out[1][0] = __builtin_amdgcn_mfma_f32_32x32x16_bf16(aQd1, So0, out[1][0], 0, 0, 0); out[1][1] = __builtin_amdgcn_mfma_f32_32x32x16_bf16(aQd1, So1, out[1][1], 0, 0, 0);
            sc[0] = __builtin_amdgcn_mfma_f32_32x32x16_bf16(aKm0, aQm0, sc[0], 0, 0, 0); sc[1] = __builtin_amdgcn_mfma_f32_32x32x16_bf16(aKm0, aQm1, sc[1], 0, 0, 0);
            sc[2] = __builtin_amdgcn_mfma_f32_32x32x16_bf16(aKm1, aQm1, sc[2], 0, 0, 0);
        }
        { int vlm = vl, him = hi; asm volatile("" : "+v"(vlm), "+v"(him));
          _Pragma("unroll") for (int r = 0; r < 16; ++r) { const bool keep = crow_(r, him) <= vlm; sc[0][r] = keep ? sc[0][r] : 0.f; sc[2][r] = keep ? sc[2][r] : 0.f; } }
        LDS_WAIT();
        const int trb3 = tr_lane_off(lane, 4);
#pragma unroll
        for (int kk = 0; kk < 2; ++kk) {
            bf16x8 Vo[2][2];
#pragma unroll
            for (int ms = 0; ms < 2; ++ms)
#pragma unroll
                for (int nt = 0; nt < 2; ++nt) {
#if MK_TRREAD
                    Vo[ms][nt] = cat44(lds_tr4(wl + trb3 + (32 * ms + 16 * kk) * 128 + 64 * nt), lds_tr4(wl + trb3 + (32 * ms + 16 * kk + 8) * 128 + 64 * nt));
#else
                    unsigned w[4];
#pragma unroll
                    for (int jj = 0; jj < 4; ++jj) { const int j0 = 2 * jj; const int s0 = 32 * ms + 16 * kk + 4 * hi + (j0 & 3) + 8 * (j0 >> 2);
                        const unsigned lo = *(const LAS unsigned short*)(wl + s0 * 128 + (vl + 32 * nt) * 2), hh = *(const LAS unsigned short*)(wl + (s0 + 1) * 128 + (vl + 32 * nt) * 2); w[jj] = lo | (hh << 16); }
                    Vo[ms][nt] = mk8(w[0], w[1], w[2], w[3]);
#endif
                }
            bf16x8 P[3];
#pragma unroll
            for (int q = 0; q < 3; ++q) P[q] = mk8(pg8::cvt_pk_bf16(sc[q][8 * kk], sc[q][8 * kk + 1]), pg8::cvt_pk_bf16(sc[q][8 * kk + 2], sc[q][8 * kk + 3]), pg8::cvt_pk_bf16(sc[q][8 * kk + 4], sc[q][8 * kk + 5]), pg8::cvt_pk_bf16(sc[q][8 * kk + 6], sc[q][8 * kk + 7]));
#pragma unroll
            for (int nt = 0; nt < 2; ++nt) {
                out[0][nt] = __builtin_amdgcn_mfma_f32_32x32x16_bf16(P[0], Vo[0][nt], out[0][nt], 0, 0, 0);
                out[1][nt] = __builtin_amdgcn_mfma_f32_32x32x16_bf16(P[1], Vo[0][nt], out[1][nt], 0, 0, 0);
                out[1][nt] = __builtin_amdgcn_mfma_f32_32x32x16_bf16(P[2], Vo[1][nt], out[1][nt], 0, 0, 0); }
        }
        LDS_WAIT(); asm volatile("" ::: "memory");
        v4u gq[8];
#pragma unroll
        for (int ch = 0; ch < 8; ++ch) gq[ch] = *(const v4u*)(HG + row * 512 + h * 64 + ch * 8);
#pragma unroll
        for (int mt = 0; mt < 2; ++mt)
#pragma unroll
            for (int nt = 0; nt < 2; ++nt)
#pragma unroll
                for (int r = 0; r < 16; ++r) *(LAS unsigned short*)(wl + (32 * mt + crow_(r, hi)) * 144 + (32 * nt + vl) * 2) = (unsigned short)(pg8::cvt_pk_bf16(out[mt][nt][r], 0.f) & 0xffffu);
        LDS_WAIT(); asm volatile("" ::: "memory");
        float vv[64]; float ss = 0.f;
#pragma unroll
        for (int ch = 0; ch < 8; ++ch) { const v4u x = *(const LAS v4u*)(wl + lane * 144 + ch * 16); const unsigned xw[4] = {x.x, x.y, x.z, x.w};
#pragma unroll
            for (int q = 0; q < 4; ++q) { const float a = __uint_as_float(xw[q] << 16), bq = __uint_as_float(xw[q] & 0xffff0000u); vv[ch * 8 + 2 * q] = a; vv[ch * 8 + 2 * q + 1] = bq; ss += a * a + bq * bq; } }
        const float rs = rsqrtf(ss * (1.0f / 64.0f) + 1e-6f);
#pragma unroll
        for (int ch = 0; ch < 8; ++ch) { const unsigned gw[4] = {gq[ch].x, gq[ch].y, gq[ch].z, gq[ch].w}; unsigned ow[4];
#pragma unroll
            for (int q = 0; q < 4; ++q) { const float g0 = __uint_as_float(gw[q] << 16), g1 = __uint_as_float(gw[q] & 0xffff0000u);
                ow[q] = pg8::cvt_pk_bf16(vv[ch * 8 + 2 * q] * rs * rdlane_f(gnl, ch * 8 + 2 * q) * pg8::silu_f(g0), vv[ch * 8 + 2 * q + 1] * rs * rdlane_f(gnl, ch * 8 + 2 * q + 1) * pg8::silu_f(g1)); }
            v4u o; o.x = ow[0]; o.y = ow[1]; o.z = ow[2]; o.w = ow[3]; *(v4u*)(mix + row * D + 512 + h * 64 + ch * 8) = o; }
        LDS_WAIT(); asm volatile("" ::: "memory");
    }
    asm volatile("; P3_END" ::: "memory");
}
#if MK_NAIVE_ATTN
__global__ void __launch_bounds__(256) k_fox_attn_n(const bf16* __restrict__ zb, const float* __restrict__ c, const float* __restrict__ gain, bf16* __restrict__ mix) {
    __shared__ float Ks[64][64]; __shared__ float Vs[64][64]; __shared__ float Cs[64];
    const int qb = blockIdx.x, bh = blockIdx.y, b = bh / NHEAD, h = bh % NHEAD, tid = threadIdx.x;
    const int qi = qb * 256 + tid; const size_t rowq = (size_t)(b * SEQ + qi);
    const bf16* Q = zb; const bf16* K = zb + ZARR; const bf16* V = zb + 2 * ZARR;
    float q[64], o[64];
#pragma unroll
    for (int d = 0; d < 64; ++d) { q[d] = pg8::bf2f(Q[rowq * 512 + h * HD + d]) * LN2; o[d] = 0.f; }
    const float cq = c[(size_t)bh * SEQ + qi]; float mx = -1e30f, l = 0.f;
    const int ntile = (qb * 256 + 256) / 64;
    for (int kt = 0; kt < ntile; ++kt) {
        __syncthreads();
        for (int e = tid; e < 64 * 64; e += 256) { const int r = e / 64, cc = e % 64; const size_t rk = (size_t)(b * SEQ + kt * 64 + r);
            Ks[r][cc] = pg8::bf2f(K[rk * 512 + h * HD + cc]); Vs[r][cc] = pg8::bf2f(V[rk * 512 + h * HD + cc]); }
        if (tid < 64) Cs[tid] = c[(size_t)bh * SEQ + kt * 64 + tid];
        __syncthreads();
        for (int j = 0; j < 64; ++j) {
            const int kj = kt * 64 + j; if (kj > qi) break;
            float s = 0.f;
#pragma unroll
            for (int d = 0; d < 64; ++d) s += q[d] * Ks[j][d];
            s += cq - Cs[j];
            if (s > mx) { const float f = __expf(mx - s); l *= f;
#pragma unroll
                for (int d = 0; d < 64; ++d) o[d] *= f;
                mx = s; }
            const float pw = __expf(s - mx); l += pw;
#pragma unroll
            for (int d = 0; d < 64; ++d) o[d] += pw * Vs[j][d];
        }
    }
    const float il = 1.f / l; float ss = 0.f;
#pragma unroll
    for (int d = 0; d < 64; ++d) { o[d] *= il; ss += o[d] * o[d]; }
    const float r = rsqrtf(ss / 64.f + 1e-6f);
#pragma unroll
    for (int d = 0; d < 64; d += 2) *(unsigned*)(mix + rowq * D + h * HD + d) = pg8::cvt_pk_bf16(o[d] * r * gain[h * HD + d], o[d + 1] * r * gain[h * HD + d + 1]);
}
#endif
#if MK_NAIVE_HGRN
__global__ void __launch_bounds__(64) k_hgrn_n(const bf16* __restrict__ zb, const float* __restrict__ lb, const float* __restrict__ gain, bf16* __restrict__ mix) {
    const int bh = blockIdx.x, b = bh / NHEAD, h = bh % NHEAD, v = threadIdx.x;
    const bf16* HQ = zb + 3 * ZARR; const bf16* HF = zb + 4 * ZARR; const bf16* HI = zb + 5 * ZARR; const bf16* HG = zb + 6 * ZARR;
    float S[64], lbv[64];
#pragma unroll
    for (int d = 0; d < 64; ++d) { S[d] = 0.f; lbv[d] = lb[h * HD + d]; }
    const float gn = gain[h * HD + v];
    for (int t = 0; t < SEQ; ++t) {
        const size_t row = (size_t)(b * SEQ + t); float o = 0.f; const float vi = pg8::bf2f(HI[row * 512 + h * HD + v]);
#pragma unroll
        for (int d = 0; d < 64; ++d) { const float f = lbv[d] + (1.f - lbv[d]) * pg8::sigm_f(pg8::bf2f(HF[row * 512 + h * HD + d])); S[d] = f * S[d] + (1.f - f) * vi; o += S[d] * pg8::bf2f(HQ[row * 512 + h * HD + d]); }
        const float ss = wave_sum(o * o); const float r = rsqrtf(ss / 64.f + 1e-6f); const float g = pg8::bf2f(HG[row * 512 + h * HD + v]);
        const float outv = o * r * gn * pg8::silu_f(g);
        mix[row * D + 512 + h * HD + v] = (bf16)(pg8::cvt_pk_bf16(outv, 0.f) & 0xffffu);
    }
}
#endif

__host__ __device__ constexpr int steps_per_layer(int i) { return (i & 1) ? 11 : 8; }
__host__ __device__ constexpr int total_steps() { return 1 + 8 + 11 + 8 + 11 + 1; }

__global__ void __launch_bounds__(NWAVES * 64, 2) mk_fwd(Args args) {
    extern __shared__ __attribute__((aligned(16))) unsigned char lds[];
    Frame F;
    F.lds = (LAS unsigned char*)lds; F.MISC = (volatile LAS unsigned*)(F.lds + MISC_OFF);
    F.tid = threadIdx.x; F.lane = F.tid & 63; F.wave = __builtin_amdgcn_readfirstlane(F.tid >> 6);
    F.G = gridDim.x; F.bx = blockIdx.x; F.gw = blockIdx.x * NWAVES + F.wave; F.NGW = F.G * NWAVES;
    F.ka = (KArgs*)__builtin_amdgcn_kernarg_segment_ptr(); F.out = args.out; F.ws = (GAS unsigned char*)args.ws;
    GAS unsigned char* ws = (GAS unsigned char*)args.ws;
    gu32* ctl = (gu32*)(ws + WS_CTL);
    for (int u = F.tid; u < (LDS_BYTES - LDSCTL_OFF) / 4; u += NWAVES * 64) ((LAS unsigned*)(F.lds + LDSCTL_OFF))[u] = 0u;
    __syncthreads();
    XcdBarrier bar = xcd_barrier_post((unsigned*)(ctl + CW_BAR) + args.li * XCD_BAR_WORDS, F.MISC + 8, F.wave);
    F.tid = 0; F.lane = 0; F.gw = 0;
    const int s_lo = args.s_lo, s_hi = args.s_hi;
    int step = 0;
#define RUN_STEP() (step >= s_lo && step < s_hi)
#define F8LAYER(l) (MK_FP8_LAST && ((l) == 3 || (MK_FP8_L1 && (l) == 1)))
#define PROBE_DUP(ids, ...) do { __VA_ARGS__; if constexpr (ids) { STEP_PRO(); __VA_ARGS__; } } while (0)
#define STEP_PRO() do { asm volatile("" : "+s"(F.wave)); F.lane = lane_id_volatile(); F.tid = F.wave * 64 + F.lane; F.bx = blockIdx.x; asm volatile("" : "+s"(F.bx));   F.gw = F.bx * NWAVES + F.wave; asm volatile("" : "+s"(ws), "+s"(F.G)); F.ws = ws; F.NGW = F.G * NWAVES; F.ka = (KArgs*)__builtin_amdgcn_kernarg_segment_ptr(); asm volatile("" : "+s"(F.ka)); } while (0)
#define END_STEP() do { if (RUN_STEP() && step + 1 < s_hi) { asm volatile("" : "+s"(bar.x)); \
        if constexpr (cv::QB > 0) xcd_barrier_idle(bar, F.wave, [&]() { constexpr int W0_ = 8 - cv::QB / 256;   \
            if (F.G == 256 && F.wave >= 2 && F.wave < 4 && step < PB_SHARES) pb_barrier_share(F, step, lane_id_volatile()); \
            if (F.G == 256 && F.wave >= W0_) { int lo_, hi_; cv::bar_range(step, lo_, hi_); const int it_ = lo_ + F.bx * (8 - W0_) + (F.wave - W0_); \
            if (it_ < hi_) conv_item(F, it_, (LAS float*)(F.lds + RING_OFF + F.wave * 16384), lane_id_volatile()); } });   \
        else xcd_barrier(bar, F.wave); \
        if constexpr (MK_PROBE == 11) { asm volatile("" : "+s"(bar.x)); xcd_barrier(bar, F.wave); } } ++step; } while (0)
static_assert(MK_ONE_LAUNCH || cv::QB == 0, "barrier-time conversion needs the one-launch step program");
#define hb ((bf16*)(ws + WS_HB))
#define h ((float*)(ws + WS_H))
#define ssq0 ((float*)(ws + WS_SSQ))
#define zb ((bf16*)(ws + WS_ZB))
#define mix ((bf16*)(ws + WS_MIX))
    int par = 0;
#define SSQ(pp) (ssq0 + (size_t)(pp) * M * 16)

    if (RUN_STEP()) { STEP_PRO(); PROBE_DUP(MK_PROBE == 1, p0_prologue(F)); }
    END_STEP();

    for (int layer = 0; layer < DEPTH; ++layer) {
        const int j = layer >> 1; const bool moe = (layer & 1) != 0;
        if (RUN_STEP()) { STEP_PRO();
            pg8::StaticOrder S; S.init(M, NIN, F.G, F.bx);
            if (F8IN(layer)) { pg8::Gemm g{(const bf16*)(ws + WS_H8), (const bf16*)(ws + WS_WIN) + (size_t)layer * NIN * D, M, NIN, D / 2, D / 2};
                pg8::EpiInT<-8> E{zb, ZARR, (float*)(ws + WS_FG), SSQ(par), C2};
                pg8::gemm_phase<pg8::EpiInT<-8>, pg8::StaticOrder, true, true, true>(F.lds + RING_OFF, g, S, E, F.tid); }
            else { pg8::Gemm g{hb, (const bf16*)(ws + WS_WIN) + (size_t)layer * NIN * D, M, NIN, D, D};
                pg8::EpiIn E{zb, ZARR, (float*)(ws + WS_FG), SSQ(par), C2};
                PROBE_DUP(MK_PROBE == 10, pg8::gemm_phase<pg8::EpiIn, pg8::StaticOrder, true, true>(F.lds + RING_OFF, g, S, E, F.tid)); }
            if (F.G == 256 && F.bx >= 192) { STEP_PRO(); const int lo = layer == 0 ? 0 : layer == 1 ? cv::D1A : layer == 2 ? cv::E3_LO : cv::E3_LO + cv::D3A, hi = layer == 0 ? cv::D1A : layer == 1 ? cv::D1B : layer == 2 ? cv::E3_LO + cv::D3A : cv::E3_LO + cv::D3B; conv_range(F, lo, hi, F.bx - 192, 64); }
        }
        END_STEP();
        if (RUN_STEP()) { STEP_PRO();
#if !MK_NAIVE_HGRN
            PROBE_DUP(MK_PROBE == 4 || MK_PROBE == 7, hgrn_pass1(F, layer));
#else
            if (F.gw < BATCH * NHEAD) fox_cscan(F, layer, F.gw);
#endif
        }
        END_STEP();
        if (RUN_STEP()) { STEP_PRO();
#if !MK_NAIVE_HGRN
            if (F.wave >= 4) { for (int bh = F.bx * 4 + (F.wave - 4); bh < BATCH * NHEAD; bh += F.G * 4) { PROBE_DUP(MK_PROBE == 4, fox_cscan(F, layer, bh)); }
                if (cv::Q_SC > 0 && F.G == 256 && F.bx >= 16) {
                    const int lo = (layer < 2 ? cv::D1N : cv::E3_LO + cv::D3N) + (layer & 1) * cv::Q_SC; LAS float* scr = (LAS float*)(F.lds + RING_OFF + F.wave * 16384);
                    for (int it = lo + (F.bx - 16) * 4 + (F.wave - 4); it < lo + cv::Q_SC; it += 240 * 4) conv_item(F, it, scr, F.lane); } }
            else { PROBE_DUP(MK_PROBE == 4 || MK_PROBE == 8, hgrn_scan(F)); }
#endif
        }
        END_STEP();
        if (RUN_STEP()) { STEP_PRO();
#if !MK_NAIVE_ATTN
            const attn_body::AttnTensors AT{(const attn_body::bf16*)zb, (const attn_body::bf16*)(zb + ZARR), (const attn_body::bf16*)(zb + 2 * ZARR), (const float*)(ws + WS_CB), KIN(F, 4) + layer * 512, (attn_body::bf16*)mix};
            const attn_body::StaticOrder S((int)F.G, F.bx);
            PROBE_DUP(MK_PROBE == 4 || MK_PROBE == 6, attn_body::attn_phase<attn_body::StaticOrder>((char*)lds + RING_OFF, AT, S, F.tid));
#endif
#if !MK_NAIVE_HGRN
            STEP_PRO(); PROBE_DUP(MK_PROBE == 4 || MK_PROBE == 9, hgrn_pass3(F, layer));
#endif
        }
        END_STEP();
        if (RUN_STEP()) { STEP_PRO();
            pg8::Gemm g{mix, (const bf16*)(ws + WS_WOUT) + (size_t)layer * D * D, M, D, D, D}; pg8::StaticOrder S; S.init(M, D, F.G, F.bx);
            typedef pg8::EpiRes<0, (long)WS_H8 - (long)WS_HB, 2> EpiOut8;
            if (!moe && F8DENSE(j)) { EpiOut8 E{hb, SSQ(par ^ 1)}; pg8::gemm_phase<EpiOut8, pg8::StaticOrder, true, true>(F.lds + RING_OFF, g, S, E, F.tid); }
            else { pg8::EpiRes<> E{hb, SSQ(par ^ 1)};
                if constexpr (MK_PROBE == 18) { pg8::EpiRes<> E0{(bf16*)(ws + WS_H + (16u << 20)), (float*)(ws + WS_H + (48u << 20))}; pg8::gemm_phase<pg8::EpiRes<>, pg8::StaticOrder, true, true>(F.lds + RING_OFF, g, S, E0, F.tid); STEP_PRO(); }
                pg8::gemm_phase<pg8::EpiRes<>, pg8::StaticOrder, true, true>(F.lds + RING_OFF, g, S, E, F.tid); }
        }
        par ^= 1;
        END_STEP();
        if (!moe) {
            if (RUN_STEP()) { STEP_PRO();
                pg8::StaticOrder S; S.init(M, 2 * DFF, F.G, F.bx);
                if (F8DENSE(j)) { pg8::Gemm g{(const bf16*)(ws + WS_H8), (const bf16*)(ws + WS_WGU) + (size_t)j * 2 * DFF * D, M, 2 * DFF, D / 2, D / 2};
                  pg8::EpiSwi8<true> E{(unsigned char*)(ws + WS_ACT), DFF, 1.0f / (F8_SX * F8_SWU), F8_SH, SSQ(par)};
                  PROBE_DUP(MK_PROBE == 15, pg8::gemm_phase<pg8::EpiSwi8<true>, pg8::StaticOrder, true, true, true>(F.lds + RING_OFF, g, S, E, F.tid));
                  if constexpr (MK_PROBE == 25) { int nv = (int)(s_lo >> 20); asm volatile("" : "+s"(nv)); pg8::EpiNull E0{(float*)(ws + WS_H + (16u << 20)), nv}; STEP_PRO();
                      pg8::gemm_phase<pg8::EpiNull, pg8::StaticOrder, true, true, true>(F.lds + RING_OFF, g, S, E0, F.tid); STEP_PRO(); pg8::gemm_phase<pg8::EpiNull, pg8::StaticOrder, true, true, true>(F.lds + RING_OFF, g, S, E0, F.tid); }
                  if constexpr (MK_PROBE == 23) { STEP_PRO(); pg8::gemm_phase<pg8::EpiSwi8<true>, pg8::StaticOrder, true, true, true>(F.lds + RING_OFF, g, S, E, F.tid); STEP_PRO(); pg8::gemm_phase<pg8::EpiSwi8<true>, pg8::StaticOrder, true, true, true>(F.lds + RING_OFF, g, S, E, F.tid); STEP_PRO(); pg8::gemm_phase<pg8::EpiSwi8<true>, pg8::StaticOrder, true, true, true>(F.lds + RING_OFF, g, S, E, F.tid); STEP_PRO(); pg8::gemm_phase<pg8::EpiSwi8<true>, pg8::StaticOrder, true, true, true>(F.lds + RING_OFF, g, S, E, F.tid); } }
                else { pg8::Gemm g{hb, (const bf16*)(ws + WS_WGU) + (size_t)j * 2 * DFF * D, M, 2 * DFF, D, D};
                  pg8::EpiSwi<true> E{(bf16*)(ws + WS_ACT), DFF, SSQ(par)};
                  PROBE_DUP(MK_PROBE == 3, pg8::gemm_phase<pg8::EpiSwi<true>, pg8::StaticOrder, true, true>(F.lds + RING_OFF, g, S, E, F.tid)); }
                if (F.G == 256 && F.bx >= 128) { STEP_PRO(); const int lo = layer == 0 ? cv::D1B : cv::E3_LO + cv::D3B, hi = layer == 0 ? cv::D1N : cv::E3_LO + cv::D3C; conv_range(F, lo, hi, F.bx - 128, 128); }
            }
            END_STEP();
            if (RUN_STEP()) { STEP_PRO();
                pg8::StaticOrder S; S.init(M, D, F.G, F.bx);
                if (F8DENSE(j)) { pg8::Gemm g{(const bf16*)(ws + WS_ACT), (const bf16*)(ws + WS_WD) + (size_t)j * D * DFF, M, D, DFF / 2, DFF / 2};
                  pg8::EpiRes<-10> E{hb, SSQ(par ^ 1)};
                  if constexpr (MK_PROBE == 19) { pg8::EpiRes<-10> E0{(bf16*)(ws + WS_H + (16u << 20)), (float*)(ws + WS_H + (48u << 20))}; pg8::gemm_phase<pg8::EpiRes<-10>, pg8::StaticOrder, true, true, true>(F.lds + RING_OFF, g, S, E0, F.tid); STEP_PRO(); }
                  pg8::gemm_phase<pg8::EpiRes<-10>, pg8::StaticOrder, true, true, true>(F.lds + RING_OFF, g, S, E, F.tid); }
                else { pg8::Gemm g{(const bf16*)(ws + WS_ACT), (const bf16*)(ws + WS_WD) + (size_t)j * D * DFF, M, D, DFF, DFF};
                  pg8::EpiRes<> E{hb, SSQ(par ^ 1)};
                  if constexpr (MK_PROBE == 19) { pg8::EpiRes<> E0{(bf16*)(ws + WS_H + (16u << 20)), (float*)(ws + WS_H + (48u << 20))}; pg8::gemm_phase<pg8::EpiRes<>, pg8::StaticOrder, true, true>(F.lds + RING_OFF, g, S, E0, F.tid); STEP_PRO(); }
                  pg8::gemm_phase<pg8::EpiRes<>, pg8::StaticOrder, true, true>(F.lds + RING_OFF, g, S, E, F.tid); }
            }
            par ^= 1;
            END_STEP();
        } else {
            if (RUN_STEP()) { STEP_PRO();
#if MK_TOUCH & 1
                mall_touch(F, WS_WEGU + (size_t)j * NE * 2 * DEXP * D * 2, (size_t)NE * 2 * DEXP * D * (F8LAYER(layer) ? 1 : 2)); STEP_PRO();
#endif
                PROBE_DUP(MK_PROBE == 5 || MK_PROBE == 12, moe_route_a(F, j)); }
            END_STEP();
            if (RUN_STEP()) { STEP_PRO();
#if MK_TOUCH & 2
                mall_touch(F, WS_WED + (size_t)j * NE * D * DEXP * 2, (size_t)NE * D * DEXP * (F8LAYER(layer) ? 1 : 2)); STEP_PRO();
#endif
                PROBE_DUP(MK_PROBE == 5, moe_route_b(F, F8LAYER(layer))); }
            END_STEP();
            if (RUN_STEP()) { STEP_PRO();
                const int* meta = (const int*)(ws + WS_META);
                pg8::MoeOrder S; S.nN = DEXP / 128; S.G = F.G; S.c = F.bx;
#pragma unroll
                for (int e = 0; e < 9; ++e) S.tpre[e] = __builtin_amdgcn_readfirstlane(meta[e]);
                S.nM = S.tpre[8]; S.nwg = S.nM * S.nN; S.nlim = S.nwg;
                if (F8LAYER(layer)) {
                    pg8::Gemm g{(const bf16*)(ws + WS_XG), (const bf16*)(ws + WS_WEGU) + (size_t)j * NE * 2 * DEXP * D, SLOTS, 2 * DEXP, D / 2, D / 2};
                    pg8::EpiSwi8<false> E{(unsigned char*)(ws + WS_HGB), DEXP, 1.0f / (F8_SX * F8_SWU), F8_SH, nullptr};
                    if constexpr (MK_PROBE == 24) { int nv = (int)(s_lo >> 20); asm volatile("" : "+s"(nv)); pg8::EpiNull E0{(float*)(ws + WS_HGB) + (size_t)SLOTS * DEXP / 4, nv};
                        pg8::gemm_phase<pg8::EpiNull, pg8::MoeOrder, true, true, true>(F.lds + RING_OFF, g, S, E0, F.tid); STEP_PRO(); }
                    if constexpr (MK_PROBE == 21 || MK_PROBE == 22) { pg8::EpiSwi8<false> E0{(unsigned char*)(ws + WS_HGB) + (size_t)SLOTS * DEXP, DEXP, 1.0f / (F8_SX * F8_SWU), F8_SH, nullptr}; pg8::MoeOrder S0 = S; S0.emask = (MK_PROBE == 21) ? 0 : 7;
                        pg8::gemm_phase<pg8::EpiSwi8<false>, pg8::MoeOrder, true, true, true>(F.lds + RING_OFF, g, S0, E0, F.tid); STEP_PRO(); }
                    PROBE_DUP(MK_PROBE == 13, pg8::gemm_phase<pg8::EpiSwi8<false>, pg8::MoeOrder, true, true, true>(F.lds + RING_OFF, g, S, E, F.tid));
                } else {
                pg8::Gemm g{(const bf16*)(ws + WS_XG), (const bf16*)(ws + WS_WEGU) + (size_t)j * NE * 2 * DEXP * D, SLOTS, 2 * DEXP, D, D};
                pg8::EpiSwi<false> E{(bf16*)(ws + WS_HGB), DEXP, nullptr};
                PROBE_DUP(MK_PROBE == 2, pg8::gemm_phase<pg8::EpiSwi<false>, pg8::MoeOrder, true, true>(F.lds + RING_OFF, g, S, E, F.tid));
                }
                if (F.G == 256 && layer == 1) { const int rounds = (S.nwg + 255) / 256, c0 = S.nwg - (rounds - 1) * 256, nidle = 256 - c0; const bool all = nidle < 96;
                    if (all || F.bx >= c0) { STEP_PRO(); const int lo = cv::E3_LO + cv::D3C; conv_range(F, lo, lo + cv::Q_MUP, all ? F.bx : F.bx - c0, all ? 256 : nidle); } }
            }
            END_STEP();
            if (RUN_STEP()) { STEP_PRO();
                const int* meta = (const int*)(ws + WS_META);
                pg8::MoeOrder S; S.nN = D / 256; S.G = F.G; S.c = F.bx;
#pragma unroll
                for (int e = 0; e < 9; ++e) S.tpre[e] = __builtin_amdgcn_readfirstlane(meta[e]);
                S.nM = S.tpre[8]; S.nwg = S.nM * S.nN;
                int L0, nleft; pg8::moe_split_plan(S.nwg, F.G, L0, nleft); S.nlim = L0;
                if (F8LAYER(layer)) {
                    pg8::Gemm g{(const bf16*)(ws + WS_HGB), (const bf16*)(ws + WS_WED) + (size_t)j * NE * D * DEXP, SLOTS, D, DEXP / 2, DEXP / 2};
                    pg8::EpiPlain E{(bf16*)(ws + WS_XG), D, 1.0f / (F8_SH * F8_SWD)};
                    if constexpr (MK_PROBE == 26) { int nv = (int)(s_lo >> 20); asm volatile("" : "+s"(nv)); pg8::EpiNull E0{(float*)(ws + WS_H + (16u << 20)), nv};
                        pg8::gemm_phase<pg8::EpiNull, pg8::MoeOrder, true, true, true>(F.lds + RING_OFF, g, S, E0, F.tid); STEP_PRO(); pg8::gemm_phase<pg8::EpiNull, pg8::MoeOrder, true, true, true>(F.lds + RING_OFF, g, S, E0, F.tid); STEP_PRO(); }
                    PROBE_DUP(MK_PROBE == 14, pg8::gemm_phase<pg8::EpiPlain, pg8::MoeOrder, true, true, true>(F.lds + RING_OFF, g, S, E, F.tid));
                    if (nleft > 0) { STEP_PRO();
                        const int split = nleft * 7 <= (int)F.G ? 7 : 2;
                        pg8::LeftOrder S2; S2.base = S; S2.L0 = L0; S2.nleft = nleft; S2.c = F.bx; S2.kq_len = DEXP / 2 / split; S2.split = split;
                        pg8::Gemm g2{(const bf16*)(ws + WS_HGB), (const bf16*)(ws + WS_WED) + (size_t)j * NE * D * DEXP, SLOTS, D, DEXP / 2 / split, DEXP / 2};
                        pg8::EpiPlainSplit E2{(bf16*)(ws + WS_XG), (bf16*)(ws + WS_YP), 1.0f / (F8_SH * F8_SWD), split - 1};
                        PROBE_DUP(MK_PROBE == 14, pg8::gemm_phase<pg8::EpiPlainSplit, pg8::LeftOrder, true, true, true>(F.lds + RING_OFF, g2, S2, E2, F.tid)); }
                } else {
                pg8::Gemm g{(const bf16*)(ws + WS_HGB), (const bf16*)(ws + WS_WED) + (size_t)j * NE * D * DEXP, SLOTS, D, DEXP, DEXP};
                pg8::EpiPlain E{(bf16*)(ws + WS_XG), D, 1.0f};
                PROBE_DUP(MK_PROBE == 2, pg8::gemm_phase<pg8::EpiPlain, pg8::MoeOrder, true, true>(F.lds + RING_OFF, g, S, E, F.tid));
                if (nleft > 0) { STEP_PRO();
                    pg8::LeftOrder S2; S2.base = S; S2.L0 = L0; S2.nleft = nleft; S2.c = F.bx; S2.kq_len = DEXP / 4; S2.split = 4;
                    pg8::Gemm g2{(const bf16*)(ws + WS_HGB), (const bf16*)(ws + WS_WED) + (size_t)j * NE * D * DEXP, SLOTS, D, DEXP / 4, DEXP};
                    pg8::EpiPlainSplit E2{(bf16*)(ws + WS_XG), (bf16*)(ws + WS_YP), 1.0f, 3};
                    pg8::gemm_phase<pg8::EpiPlainSplit, pg8::LeftOrder, true, true>(F.lds + RING_OFF, g2, S2, E2, F.tid); }
                }
            }
            END_STEP();
            if (RUN_STEP()) { STEP_PRO(); moe_combine(F, SSQ(par ^ 1), F8LAYER(layer)); }
            par ^= 1;
            END_STEP();
        }
        if (RUN_STEP()) { STEP_PRO();
            { pg8::Gemm g{(const bf16*)(ws + WS_PB) + (size_t)layer * M * DPLE, (const bf16*)(ws + WS_WPLE) + (size_t)layer * D * DPLE, M, D, DPLE, DPLE}; pg8::StaticOrder S; S.init(M, D, F.G, F.bx);
              pg8::EpiP2 E{(bf16*)(ws + WS_P2)};
              PROBE_DUP(MK_PROBE == 16, pg8::gemm_phase<pg8::EpiP2, pg8::StaticOrder, true, true>(F.lds + RING_OFF, g, S, E, F.tid)); }
            STEP_PRO();
            { pg8::Gemm g{hb, (const bf16*)(ws + WS_WPG) + (size_t)layer * D * D, M, D, D, D}; pg8::StaticOrder S; S.init(M, D, F.G, F.bx);
              typedef pg8::EpiPleT<(long)WS_H8 - (long)WS_HB, 2> EpiPle8;
              if (layer + 1 < DEPTH && F8IN(layer + 1)) { EpiPle8 E{(const bf16*)(ws + WS_P2), hb, SSQ(par), SSQ(par ^ 1)}; pg8::gemm_phase<EpiPle8, pg8::StaticOrder, true, true>(F.lds + RING_OFF, g, S, E, F.tid); }
              else { pg8::EpiPle E{(const bf16*)(ws + WS_P2), hb, SSQ(par), SSQ(par ^ 1)};
                if constexpr (MK_PROBE == 20) { pg8::EpiPle E0{(const bf16*)(ws + WS_P2), (bf16*)(ws + WS_H + (16u << 20)), SSQ(par), (float*)(ws + WS_H + (48u << 20))}; pg8::gemm_phase<pg8::EpiPle, pg8::StaticOrder, true, true>(F.lds + RING_OFF, g, S, E0, F.tid); STEP_PRO(); }
                pg8::gemm_phase<pg8::EpiPle, pg8::StaticOrder, true, true>(F.lds + RING_OFF, g, S, E, F.tid); } }
        }
        par ^= 1;
        END_STEP();
    }
    if (RUN_STEP()) { STEP_PRO(); PROBE_DUP(MK_PROBE == 17, final_norm(F)); }
    END_STEP();
#undef RUN_STEP
#undef hb
#undef h
#undef ssq0
#undef zb
#undef mix
#undef END_STEP
#undef SSQ
}

extern "C" void kernel_launch(void* const* d_in, const int* in_sizes, int n_in, void* d_out, int out_size, void* d_ws, size_t ws_size, hipStream_t stream) {
    static int grid = 0;
    if (grid == 0) {
        if (n_in != 21 || out_size != M * D || ws_size < WS_END) { fprintf(stderr, "kernel_launch: unexpected problem (n_in %d out %d ws %zu need %zu)\n", n_in, out_size, ws_size, (size_t)WS_END); grid = -1; return; }
        int dev = 0, cus = 0, per_cu = 0;
        if (hipGetDevice(&dev) != hipSuccess || hipDeviceGetAttribute(&cus, hipDeviceAttributeMultiprocessorCount, dev) != hipSuccess) { grid = -1; return; }
        if (hipFuncSetAttribute((const void*)mk_fwd, hipFuncAttributeMaxDynamicSharedMemorySize, LDS_BYTES) != hipSuccess) { grid = -1; return; }
        if (hipOccupancyMaxActiveBlocksPerMultiprocessor(&per_cu, (const void*)mk_fwd, NWAVES * 64, LDS_BYTES) != hipSuccess || per_cu < 1) { fprintf(stderr, "kernel_launch: occupancy query says %d\n", per_cu); }
        (void)hipGetLastError();
        grid = cus;
    }
    if (grid < 0) return;
    (void)hipMemsetAsync((char*)d_ws + WS_CTL, 0, CTL_ZERO_BYTES, stream);
    Args a{};
    for (int i = 0; i < 21; ++i) a.in[i] = (const float*)d_in[i];
    a.out = (float*)d_out; a.ws = (unsigned char*)d_ws;
#if MK_ONE_LAUNCH
    a.s_lo = 0; a.s_hi = total_steps(); a.li = 0;
    hipLaunchKernelGGL(mk_fwd, dim3(grid), dim3(NWAVES * 64), LDS_BYTES, stream, a);
#else
    int step = 0, li = 0;
    auto launch1 = [&](int s) { a.s_lo = s; a.s_hi = s + 1; a.li = li % MAX_BAR_REGIONS; ++li; hipLaunchKernelGGL(mk_fwd, dim3(grid), dim3(NWAVES * 64), LDS_BYTES, stream, a); };
    launch1(step++);
    for (int layer = 0; layer < DEPTH; ++layer) {
        const int n = steps_per_layer(layer);
        for (int k = 0; k < n; ++k) {
            launch1(step++);
            if (k == 1) {
                const bf16* zb = (const bf16*)((char*)d_ws + WS_ZB); bf16* mix = (bf16*)((char*)d_ws + WS_MIX);
                (void)zb; (void)mix;
#if MK_NAIVE_ATTN
                k_fox_attn_n<<<dim3(SEQ / 256, BATCH * NHEAD), 256, 0, stream>>>(zb, (const float*)((char*)d_ws + WS_CB), (const float*)d_in[4] + layer * 512, mix);
#endif
#if MK_NAIVE_HGRN
                k_hgrn_n<<<BATCH * NHEAD, 64, 0, stream>>>(zb, (const float*)((char*)d_ws + WS_LB) + layer * 512, (const float*)d_in[6] + layer * 512, mix);
#endif
            }
        }
    }
    launch1(step++);
#endif
}
```
